# Optimizing an MI355X kernel written in HIP

```python
import math
import jax, jax.numpy as jnp
from jax import lax
import numpy as np

D_MODEL = 1024
BATCH = 32
SEQ = 2048
DEPTH = 2
DEC_BATCH = 2
DEC_SEQ = 8192
PAST_LEN = 128

N_MIXERS = 2
HEAD_DIM = 64
HEADS_PER_GROUP = D_MODEL // HEAD_DIM
DILATED_GROUPS = ((128, 1), (512, 4), (2048, 16))
N_GROUPS = len(DILATED_GROUPS)
N_ATTN_HEADS = N_GROUPS * HEADS_PER_GROUP
NUM_BUCKETS = 32
MAX_DISTANCE = 1024
HYENA_ORDER = 2
HYENA_DIRS = 2
HYENA_EMB_DIM = 33
HYENA_FILTER_WIDTH = 64
SHORT_CONV = 3
FAST_DECAY_PCT = 0.3
SLOW_DECAY_PCT = 1.5
DECAY_TARGET = 1e-2
D_FF = 2816
RMS_EPS = 1e-6
N_ATTN_LAYERS = (DEPTH + 1) // 2
N_HYENA_LAYERS = DEPTH // 2

kernel_name = 'hybrid_dilated_attn_hyena_encoder'


def _rms_norm(x, g):
    xf = x.astype(jnp.float32)
    y = xf * lax.rsqrt(jnp.mean(xf * xf, axis=-1, keepdims=True) + RMS_EPS)
    return (y * g.astype(jnp.float32)).astype(x.dtype)


def _swiglu(xn, w_gate_up, w_down):
    gate, up = jnp.split(xn @ w_gate_up, 2, axis=-1)
    return (jax.nn.silu(gate) * up) @ w_down


def _t5_bucket(rel):
    nb = NUM_BUCKETS // 2
    max_exact = nb // 2
    ret = (rel > 0).astype(np.int32) * nb
    n = np.abs(rel)
    large = max_exact + (np.log(np.maximum(n, 1) / max_exact)
                         / math.log(MAX_DISTANCE / max_exact) * (nb - max_exact)).astype(np.int32)
    large = np.minimum(large, nb - 1)
    return ret + np.where(n < max_exact, n, large)


def _dilated_group_attention(q, k, v, bias_g, dilation, half_window):
    B, S, H, E = q.shape
    d = dilation
    w = half_window // d
    lc = S // d
    nb = -(-lc // w)
    lp = nb * w

    def classes(t):
        return t.reshape(B, lc, d, H, E).transpose(0, 2, 1, 3, 4).reshape(B * d, lc, H, E)

    def banded(t):
        tp = jnp.pad(classes(t), ((0, 0), (w, lp - lc + w), (0, 0), (0, 0)))
        tp = tp.reshape(B * d, nb + 2, w, H, E)
        return jnp.concatenate([tp[:, :-2], tp[:, 1:-1], tp[:, 2:]], axis=2)

    qc = jnp.pad(classes(q), ((0, 0), (0, lp - lc), (0, 0), (0, 0))).reshape(B * d, nb, w, H, E)
    kb = banded(k)
    vb = banded(v)
    s = jnp.einsum('bnqhe,bnkhe->bnhqk', qc, kb,
                   preferred_element_type=jnp.float32) * (E ** -0.5)
    delta = np.arange(3 * w)[None, :] - w - np.arange(w)[:, None]
    bias = bias_g.astype(jnp.float32)[_t5_bucket(delta * d)].transpose(2, 0, 1)
    key_pos = np.arange(nb)[:, None] * w - w + np.arange(3 * w)[None, :]
    mask = (np.abs(delta) <= w)[None] & ((key_pos >= 0) & (key_pos < lc))[:, None, :]
    s = jnp.where(mask[None, :, None], s + bias, -jnp.inf)
    m = jnp.max(s, axis=-1, keepdims=True)
    p = jnp.exp(s - m)
    l = jnp.sum(p, axis=-1, keepdims=True)
    o = jnp.einsum('bnhqk,bnkhe->bnqhe', p, vb) / jnp.moveaxis(l, 2, 3)
    lse = jnp.moveaxis((m + jnp.log(l))[..., 0], 2, 3)
    o = o.reshape(B, d, lp, H, E)[:, :, :lc].transpose(0, 2, 1, 3, 4).reshape(B, S, H, E)
    lse = lse.reshape(B, d, lp, H)[:, :, :lc].transpose(0, 2, 1, 3).reshape(B, S, H)
    return o, lse


def _dilated_attention(xn, w_qkv, w_o, rel_bias):
    B, S, _ = xn.shape
    qkv = (xn @ w_qkv).reshape(B, S, N_GROUPS, 3, HEADS_PER_GROUP, HEAD_DIM)
    outs, lses = [], []
    for g, (window, dil) in enumerate(DILATED_GROUPS):
        o, lse = _dilated_group_attention(
            qkv[:, :, g, 0], qkv[:, :, g, 1], qkv[:, :, g, 2],
            rel_bias[:, g * HEADS_PER_GROUP:(g + 1) * HEADS_PER_GROUP], dil, window // 2)
        outs.append(o)
        lses.append(lse)
    alpha = jax.nn.softmax(jnp.stack(lses), axis=0)
    o = jnp.einsum('gbsh,gbshe->bshe', alpha, jnp.stack(outs))
    return o.reshape(B, S, D_MODEL).astype(xn.dtype) @ w_o


def _hyena_filters(L, w1, b1, w2, b2, w3, b3, freq, w4):
    f32 = jnp.float32
    t = jnp.linspace(0.0, 1.0, L, dtype=f32)[:, None]
    bands = (HYENA_EMB_DIM - 1) // 2
    wpos = 2.0 * math.pi * jnp.arange(L, dtype=f32)[:, None] / L
    fr = jnp.linspace(1e-4, bands - 1, bands, dtype=f32)[None, :]
    z = jnp.concatenate([t, jnp.cos(fr * wpos), -jnp.sin(fr * wpos)], axis=-1)
    fq = freq.astype(f32)
    h = jnp.sin(fq * (z @ w1.astype(f32) + b1.astype(f32)))
    h = jnp.sin(fq * (h @ w2.astype(f32) + b2.astype(f32)))
    h = jnp.sin(fq * (h @ w3.astype(f32) + b3.astype(f32)))
    h = h @ w4.astype(f32)
    max_decay = math.log(DECAY_TARGET) / FAST_DECAY_PCT
    min_decay = math.log(DECAY_TARGET) / SLOW_DECAY_PCT
    deltas = jnp.linspace(min_decay, max_decay, D_MODEL, dtype=f32)
    decay = jnp.exp(-t * jnp.abs(deltas))
    return h.reshape(L, HYENA_ORDER, HYENA_DIRS, D_MODEL) * decay[:, None, None, :]


def _bidirectional_spectrum(h):
    fwd = h[:, :, 0]
    bwd = h[:, :, 1]
    k = jnp.concatenate([fwd, jnp.zeros_like(fwd[:1]), bwd[1:][::-1]], axis=0)
    return jnp.fft.rfft(k, axis=0)


def _hyena(xn, w_in, conv_w, conv_b, w1, b1, w2, b2, w3, b3, freq, w4, skip, w_out):
    B, L, D = xn.shape
    u = xn @ w_in
    pad = (SHORT_CONV - 1) // 2
    up = jnp.pad(u, ((0, 0), (pad, pad), (0, 0)))
    u = sum(up[:, j:j + L] * conv_w[j] for j in range(SHORT_CONV)) + conv_b
    u = u.astype(jnp.float32)
    x1, x2, z = u[..., :D], u[..., D:2 * D], u[..., 2 * D:]
    kf = _bidirectional_spectrum(_hyena_filters(L, w1, b1, w2, b2, w3, b3, freq, w4))
    skipf = skip.astype(jnp.float32)
    for o, gate in enumerate((x1, x2)):
        zf = jnp.fft.rfft(z, n=2 * L, axis=1)
        conv = jnp.fft.irfft(zf * kf[None, :, o], n=2 * L, axis=1)[:, :L]
        z = gate * (conv + z * skipf[o])
    return z.astype(xn.dtype) @ w_out


def _trunk(x, rel_bias, ffn1_norm, ffn1_w_gate_up, ffn1_w_down, mixer_norm, attn_w_qkv, attn_w_o,
           hyena_w_in, hyena_conv_w, hyena_conv_b, hyena_filt_w1, hyena_filt_b1, hyena_filt_w2,
           hyena_filt_b2, hyena_filt_w3, hyena_filt_b3, hyena_filt_freq, hyena_filt_w4, hyena_skip,
           hyena_w_out, ffn2_norm, ffn2_w_gate_up, ffn2_w_down, final_norm):
    for i in range(DEPTH):
        x = x + 0.5 * _swiglu(_rms_norm(x, ffn1_norm[i]), ffn1_w_gate_up[i], ffn1_w_down[i])
        h = _rms_norm(x, mixer_norm[i])
        j = i // N_MIXERS
        if i % N_MIXERS == 0:
            x = x + _dilated_attention(h, attn_w_qkv[j], attn_w_o[j], rel_bias)
        else:
            x = x + _hyena(h, hyena_w_in[j], hyena_conv_w[j], hyena_conv_b[j],
                           hyena_filt_w1[j], hyena_filt_b1[j], hyena_filt_w2[j], hyena_filt_b2[j],
                           hyena_filt_w3[j], hyena_filt_b3[j], hyena_filt_freq[j], hyena_filt_w4[j],
                           hyena_skip[j], hyena_w_out[j])
        x = x + 0.5 * _swiglu(_rms_norm(x, ffn2_norm[i]), ffn2_w_gate_up[i], ffn2_w_down[i])
    return _rms_norm(x, final_norm)


def setup_inputs(seed: int = 0) -> dict:
    key = jax.random.key(seed)
    ks = jax.random.split(key, 32)
    f32 = jnp.float32

    def nrm(k, shape, scale):
        return jax.random.normal(k, shape, f32) * scale

    D, F, NA, NH, FW = D_MODEL, D_FF, N_ATTN_LAYERS, N_HYENA_LAYERS, HYENA_FILTER_WIDTH
    return {
        'x_prompt': nrm(ks[0], (BATCH, SEQ, D), 1.0),
        'x_sample': nrm(ks[1], (DEC_BATCH, DEC_SEQ, D), 1.0),
        'rel_bias': nrm(ks[2], (NUM_BUCKETS, N_ATTN_HEADS), 0.5),
        'ffn1_norm': 1.0 + nrm(ks[3], (DEPTH, D), 0.05),
        'ffn1_w_gate_up': nrm(ks[4], (DEPTH, D, 2 * F), D ** -0.5),
        'ffn1_w_down': nrm(ks[5], (DEPTH, F, D), F ** -0.5),
        'mixer_norm': 1.0 + nrm(ks[6], (DEPTH, D), 0.05),
        'attn_w_qkv': nrm(ks[7], (NA, D, N_GROUPS * 3 * D), D ** -0.5),
        'attn_w_o': nrm(ks[8], (NA, D, D), D ** -0.5),
        'hyena_w_in': nrm(ks[9], (NH, D, 3 * D), D ** -0.5),
        'hyena_conv_w': nrm(ks[10], (NH, SHORT_CONV, 3 * D), SHORT_CONV ** -0.5),
        'hyena_conv_b': nrm(ks[11], (NH, 3 * D), 0.02),
        'hyena_filt_w1': nrm(ks[12], (NH, HYENA_EMB_DIM, FW), HYENA_EMB_DIM ** -0.5),
        'hyena_filt_b1': nrm(ks[13], (NH, FW), 0.1),
        'hyena_filt_w2': nrm(ks[14], (NH, FW, FW), FW ** -0.5),
        'hyena_filt_b2': nrm(ks[15], (NH, FW), 0.1),
        'hyena_filt_w3': nrm(ks[16], (NH, FW, FW), FW ** -0.5),
        'hyena_filt_b3': nrm(ks[17], (NH, FW), 0.1),
        'hyena_filt_freq': 1.0 + nrm(ks[18], (NH, FW), 0.1),
        'hyena_filt_w4': nrm(ks[19], (NH, FW, HYENA_ORDER * HYENA_DIRS * D), 0.03 * FW ** -0.5),
        'hyena_skip': nrm(ks[20], (NH, HYENA_ORDER, D), 1.0),
        'hyena_w_out': nrm(ks[21], (NH, D, D), D ** -0.5),
        'ffn2_norm': 1.0 + nrm(ks[22], (DEPTH, D), 0.05),
        'ffn2_w_gate_up': nrm(ks[23], (DEPTH, D, 2 * F), D ** -0.5),
        'ffn2_w_down': nrm(ks[24], (DEPTH, F, D), F ** -0.5),
        'final_norm': 1.0 + nrm(ks[25], (D,), 0.05),
    }


def reference(x_prompt, x_sample, rel_bias, ffn1_norm, ffn1_w_gate_up, ffn1_w_down, mixer_norm,
              attn_w_qkv, attn_w_o, hyena_w_in, hyena_conv_w, hyena_conv_b, hyena_filt_w1,
              hyena_filt_b1, hyena_filt_w2, hyena_filt_b2, hyena_filt_w3, hyena_filt_b3,
              hyena_filt_freq, hyena_filt_w4, hyena_skip, hyena_w_out, ffn2_norm, ffn2_w_gate_up,
              ffn2_w_down, final_norm):
    weights = (rel_bias, ffn1_norm, ffn1_w_gate_up, ffn1_w_down, mixer_norm, attn_w_qkv, attn_w_o,
               hyena_w_in, hyena_conv_w, hyena_conv_b, hyena_filt_w1, hyena_filt_b1, hyena_filt_w2,
               hyena_filt_b2, hyena_filt_w3, hyena_filt_b3, hyena_filt_freq, hyena_filt_w4,
               hyena_skip, hyena_w_out, ffn2_norm, ffn2_w_gate_up, ffn2_w_down, final_norm)
    y_prompt = _trunk(x_prompt, *weights)
    y_sample = _trunk(x_sample, *weights)
    return (y_prompt, y_sample)
```

```cpp
#include <hip/hip_runtime.h>
#include <hip/hip_cooperative_groups.h>
#include <cstdio>
namespace cg = cooperative_groups;
namespace pg8 {
#define PG8_LAS __attribute__((address_space(3)))
typedef unsigned short bf16_t;
typedef short bf16x8 __attribute__((ext_vector_type(8)));
typedef float f32x4 __attribute__((ext_vector_type(4)));
typedef unsigned u32x4 __attribute__((ext_vector_type(4)));
constexpr int BM = 256, BK = 64, HALF = 128, HTB = HALF * BK * 2  , STAGE_BYTES = 8 * HTB, NXCD = 8, WGM = 8;

__host__ __device__ __forceinline__ int lds_byte(int r, int c) { const int st = (r >> 4) * 2 + (c >> 5), rr = r & 15, cc = c & 31, ob = rr * 64 + cc * 2; return st * 1024 + (ob ^ (((ob >> 9) & 1) << 5)); }
__host__ __device__ __forceinline__ void stage_rc(int b, int& R, int& C) { const int st = b / 1024, sb = b % 1024, swz = sb ^ (((sb >> 9) & 1) << 5); R = (st >> 1) * 16 + swz / 64; C = (st & 1) * 32 + (swz % 64) / 2; }
__host__ __device__ __forceinline__ int perm32(int rho) { const int n = rho >> 4, i = rho & 15; return 8 * (i >> 2) + 4 * n + (i & 3); }

struct Unit { int pm, pn; };
struct Gemm { const bf16_t* A; const bf16_t* Bt; int M, N, K; };

struct StaticOrder {
    int nM, nN, nwg, G, c;
    __host__ __device__ void init(int M, int N, int G_, int c_) { nM = M / BM; nN = N / BM; nwg = nM * nN; G = G_; c = c_; }
    __host__ __device__ bool next(int i, Unit& u) const {
        const long L = (long)i * G + c; if (L >= nwg) return false;
        int wgid = (int)L; { const int q = nwg / NXCD, r = nwg % NXCD, xcd = wgid % NXCD, off = wgid / NXCD; wgid = (xcd < r ? xcd * (q + 1) : r * (q + 1) + (xcd - r) * q) + off; }
        const int nig = WGM * nN, gid = wgid / nig, fm = gid * WGM, gsz = (nM - fm) < WGM ? (nM - fm) : WGM;
        u.pm = fm + ((wgid % nig) % gsz); u.pn = (wgid % nig) / gsz; return true;
    }
    __device__ __forceinline__ void a_ready(const Unit&) const {}
    __device__ __forceinline__ void done(const Unit&) const {}
};
__device__ __forceinline__ unsigned cvt_pk_bf16(float lo, float hi) { unsigned r; asm volatile("v_cvt_pk_bf16_f32 %0, %1, %2" : "=v"(r) : "v"(lo), "v"(hi)); return r; }
typedef float f32x2 __attribute__((ext_vector_type(2)));
__device__ __forceinline__ f32x2 gelu_pk(f32x2 v) {
    const f32x2 av = __builtin_elementwise_abs(v), d = av * 0.2316418882f + 1.0f;
    f32x2 t; t.x = __builtin_amdgcn_rcpf(d.x); t.y = __builtin_amdgcn_rcpf(d.y);
    f32x2 q = t * 0.5307027145f + (-0.7265760135f); q = q * t + 0.7107068705f; q = q * t + (-0.142248368f); q = q * t + 0.127414796f; q = q * t;
    const f32x2 s = (v * v) * (-0.72134752044f);
    f32x2 e; e.x = __builtin_amdgcn_exp2f(s.x); e.y = __builtin_amdgcn_exp2f(s.y);
    const f32x2 m = v * (q * e), r = v - m;
    f32x2 o; o.x = v.x < 0.f ? m.x : r.x; o.y = v.y < 0.f ? m.y : r.y; return o;
}

template <class Epi, class Sched, bool STAMP = false>
__device__ __forceinline__ void gemm_phase(PG8_LAS unsigned char* lds, const Gemm g, const Sched& S, const Epi& E, unsigned long long* stamps, const int tid) {
    const int  wid = __builtin_amdgcn_readfirstlane(tid >> 6), lane = tid & 63, wr = wid >> 2, wc = wid & 3, fr = lane & 15, fq = lane >> 4;
    const int K = g.K, nt = K / BK;
    int ts_lo = 0, ts_hi = 0, nts = 0; const unsigned long long rt_entry = STAMP ? (unsigned long long)wall_clock64() : 0ull;
#define PG8_STAMP() do { if (STAMP && wid == 0 && nts < 64) { const unsigned long long _c = (unsigned long long)clock64(); \
        ts_lo = (lane == nts) ? (int)(unsigned)_c : ts_lo; ts_hi = (lane == nts) ? (int)(unsigned)(_c >> 32) : ts_hi; ++nts; } } while (0)
    PG8_STAMP();
    unsigned voffA[2], voffB[2];
#pragma unroll
    for (int i = 0; i < 2; ++i) { int R, C; stage_rc(tid * 16 + i * 8192, R, C); const int Rb = Epi::PERM ? ((R & ~31) + perm32(R & 31)) : R;
        voffA[i] = (unsigned)(R * K + C) * 2u; voffB[i] = (unsigned)(Rb * K + C) * 2u; }
    const size_t kstep = (size_t)(BK * 2);
    const size_t hstep = (size_t)HALF * K * 2;
    const size_t tstep = 2 * hstep;
    const unsigned ldsw = (unsigned)wid * 1024u;
    const int aoff = lds_byte(wr * 64 + fr, fq * 8), boff = lds_byte(wc * 32 + fr, fq * 8);
#define PG8_SA(b, h) (((b) * 2 + (h)) * HTB)
#define PG8_SB(b, h) ((4 + (b) * 2 + (h)) * HTB)
#define PG8_STAGE(bufoff, gbase, voff) do { _Pragma("unroll") for (int _i = 0; _i < 2; ++_i) \
        __builtin_amdgcn_global_load_lds((const unsigned*)((const char*)(gbase) + (voff)[_i]), (PG8_LAS unsigned*)(lds + (bufoff) + ldsw + _i * 8192), 16, 0, 0); } while (0)
#define PG8_LDA(dst, b, h) do { _Pragma("unroll") for (int m = 0; m < 4; ++m) _Pragma("unroll") for (int k = 0; k < 2; ++k) dst[m][k] = *(const PG8_LAS bf16x8*)(lds + PG8_SA(b, h) + aoff + m * 2048 + k * 1024); } while (0)
#define PG8_LDB(dst, b, h) do { _Pragma("unroll") for (int n = 0; n < 2; ++n) _Pragma("unroll") for (int k = 0; k < 2; ++k) dst[n][k] = *(const PG8_LAS bf16x8*)(lds + PG8_SB(b, h) + boff + n * 2048 + k * 1024); } while (0)
#define PG8_MMA(ai, bj, At, Bt) do { __builtin_amdgcn_s_setprio(1); _Pragma("unroll") for (int m = 0; m < 4; ++m) _Pragma("unroll") for (int n = 0; n < 2; ++n) _Pragma("unroll") for (int k = 0; k < 2; ++k) \
        acc[ai][bj][m][n] = __builtin_amdgcn_mfma_f32_16x16x32_bf16(Bt[n][k], At[m][k], acc[ai][bj][m][n], 0, 0, 0); __builtin_amdgcn_s_setprio(0); } while (0)
#define PG8_WAIT_V(n) asm volatile("s_waitcnt vmcnt(" #n ")" ::: "memory")
#define PG8_WAIT_L(n) asm volatile("s_waitcnt lgkmcnt(" #n ")" ::: "memory")
#define PG8_BAR __builtin_amdgcn_s_barrier()
#define PG8_SCHED __builtin_amdgcn_sched_barrier(0)
    Unit cur, nxt; int ui = 0;
    if (!S.next(0, cur)) return;
    f32x4 acc[2][2][4][2];
#pragma unroll
    for (int a = 0; a < 2; ++a)
#pragma unroll
        for (int b = 0; b < 2; ++b)
#pragma unroll
            for (int m = 0; m < 4; ++m)
#pragma unroll
                for (int n = 0; n < 2; ++n) acc[a][b][m][n] = (f32x4){0.f, 0.f, 0.f, 0.f};
    bf16x8 At[4][2], B0[2][2], B1[2][2];
    const char* cA = (const char*)g.A + (size_t)cur.pm * tstep; const char* cB = (const char*)g.Bt + (size_t)cur.pn * tstep;
    S.a_ready(cur);
    PG8_STAGE(PG8_SB(0, 0), cB, voffB); PG8_STAGE(PG8_SA(0, 0), cA, voffA); PG8_STAGE(PG8_SB(0, 1), cB + hstep, voffB); PG8_STAGE(PG8_SA(0, 1), cA + hstep, voffA);
    if (wr == 1) PG8_BAR;
    PG8_WAIT_V(4); PG8_BAR;
    PG8_STAGE(PG8_SB(1, 0), cB + kstep, voffB); PG8_STAGE(PG8_SA(1, 0), cA + kstep, voffA); PG8_STAGE(PG8_SB(1, 1), cB + hstep + kstep, voffB);
    PG8_WAIT_V(6); PG8_BAR;
    PG8_STAMP();
    for (;;) {
        const bool has_next = S.next(ui + 1, nxt);
        const char* nA = has_next ? (const char*)g.A + (size_t)nxt.pm * tstep : cA; const char* nB = has_next ? (const char*)g.Bt + (size_t)nxt.pn * tstep : cB;
        for (int t = 0; t < nt; t += 2) {
            const bool last = (t == nt - 2);
            const char* a1 = cA + (size_t)(t + 1) * kstep;
            const char* a2 = last ? nA : cA + (size_t)(t + 2) * kstep; const char* b2 = last ? nB : cB + (size_t)(t + 2) * kstep;
            const char* a3 = a2 + kstep; const char* b3 = b2 + kstep;
            if (last && has_next) S.a_ready(nxt);
            PG8_LDB(B0, 0, 0); PG8_SCHED; PG8_LDA(At, 0, 0); PG8_STAGE(PG8_SA(1, 1), a1 + hstep, voffA);
            PG8_WAIT_L(8); PG8_BAR; PG8_WAIT_L(0); PG8_MMA(0, 0, At, B0); PG8_BAR; PG8_SCHED;
            PG8_LDB(B1, 0, 1); PG8_STAGE(PG8_SB(0, 0), b2, voffB);
            PG8_BAR; PG8_WAIT_L(0); PG8_MMA(0, 1, At, B1); PG8_BAR;
            PG8_LDA(At, 0, 1); PG8_STAGE(PG8_SA(0, 0), a2, voffA);
            PG8_BAR; PG8_WAIT_L(0); PG8_MMA(1, 0, At, B0); PG8_BAR; PG8_SCHED;
            PG8_STAGE(PG8_SB(0, 1), b2 + hstep, voffB);
            PG8_WAIT_V(6); PG8_BAR; PG8_MMA(1, 1, At, B1); PG8_BAR;
            PG8_LDB(B0, 1, 0); PG8_SCHED; PG8_LDA(At, 1, 0); PG8_STAGE(PG8_SA(0, 1), a2 + hstep, voffA);
            PG8_WAIT_L(8); PG8_BAR; PG8_WAIT_L(0); PG8_MMA(0, 0, At, B0); PG8_BAR; PG8_SCHED;
            PG8_LDB(B1, 1, 1); PG8_STAGE(PG8_SB(1, 0), b3, voffB);
            PG8_BAR; PG8_WAIT_L(0); PG8_MMA(0, 1, At, B1); PG8_BAR;
            PG8_LDA(At, 1, 1); PG8_STAGE(PG8_SA(1, 0), a3, voffA);
            PG8_BAR; PG8_WAIT_L(0); PG8_MMA(1, 0, At, B0); PG8_BAR; PG8_SCHED;
            PG8_STAGE(PG8_SB(1, 1), b3 + hstep, voffB);
            PG8_WAIT_V(6); PG8_BAR; PG8_MMA(1, 1, At, B1); PG8_BAR;
        }
        PG8_STAMP();
        if constexpr (!Epi::AFTER_DRAIN) { E(acc, cur, wr, wc, fr, fq); S.done(cur); }
        PG8_STAMP();
        if (!has_next) break;
#pragma unroll
        for (int a = 0; a < 2; ++a)
#pragma unroll
            for (int b = 0; b < 2; ++b)
#pragma unroll
                for (int m = 0; m < 4; ++m)
#pragma unroll
                    for (int n = 0; n < 2; ++n) acc[a][b][m][n] = (f32x4){0.f, 0.f, 0.f, 0.f};
        cur = nxt; cA = nA; cB = nB; ++ui;
    }
    PG8_WAIT_V(0);
    if (wr == 0) PG8_BAR;
    PG8_BAR;
    if constexpr (Epi::AFTER_DRAIN) { E.fused(acc, cur, wr, wc, fr, fq, lds, wid, lane); S.done(cur); }
    PG8_STAMP();
    if (STAMP && wid == 0) { stamps[lane] = lane < nts ? (((unsigned long long)(unsigned)ts_hi << 32) | (unsigned)ts_lo) : 0ull;
        if (lane == 62) stamps[62] = rt_entry; if (lane == 63) stamps[63] = (unsigned long long)wall_clock64(); }
#undef PG8_STAMP
#undef PG8_SA
#undef PG8_SB
#undef PG8_STAGE
#undef PG8_LDA
#undef PG8_LDB
#undef PG8_MMA
#undef PG8_WAIT_V
#undef PG8_WAIT_L
#undef PG8_BAR
#undef PG8_SCHED
}
}

using pg8::bf16_t; using pg8::bf16x8; using pg8::f32x4; using pg8::u32x4;
typedef float f32x16 __attribute__((ext_vector_type(16)));
typedef short s16x4 __attribute__((ext_vector_type(4)));
typedef unsigned u32x2 __attribute__((ext_vector_type(2)));
#define LAS __attribute__((address_space(3)))
#define DI __device__ __forceinline__

constexpr int DM = 1024, FF = 2816, NQKV = 9216, CT = 16384  , NCHUNK = 5, NPH = 24;
constexpr int NTHR = 512;
constexpr int LDS_BYTES = 131072 + 4096;

constexpr size_t SZ_WGU = (size_t)5632 * 1024 * 2, SZ_WDN = (size_t)1024 * 2816 * 2;
constexpr size_t WS_WGU = 0;
constexpr size_t WS_WDN = WS_WGU + 4 * SZ_WGU;
constexpr size_t WS_WQKV = WS_WDN + 4 * SZ_WDN;
constexpr size_t WS_WO = WS_WQKV + (size_t)9216 * 1024 * 2;
constexpr size_t WS_WIN = WS_WO + (size_t)1024 * 1024 * 2;
constexpr size_t WS_WOUT = WS_WIN + (size_t)3072 * 1024 * 2;
constexpr size_t WS_H3 = WS_WOUT + (size_t)1024 * 1024 * 2;
constexpr size_t WS_TW = WS_H3 + (size_t)10240 * 64 * 4;
constexpr size_t WS_BIAS = WS_TW + (size_t)8192 * 8;
constexpr size_t WS_XN = WS_BIAS + (size_t)48 * 132 * 4 + 256 - ((size_t)48 * 132 * 4) % 256;
constexpr size_t WS_H = WS_XN + (size_t)CT * 1024 * 2;
constexpr size_t WS_ATT = WS_H + (size_t)CT * 2816 * 2;
constexpr size_t WS_LSE = WS_ATT + (size_t)CT * 1024 * 2;
constexpr size_t WS_OG = WS_LSE + (size_t)CT * 48 * 4;
constexpr size_t WS_BIG = WS_OG + (size_t)CT * 3072 * 2;
constexpr size_t SZ_U = (size_t)CT * 3072 * 2;
constexpr size_t WS_KF = WS_BIG + (size_t)CT * 9216 * 2;
constexpr size_t WS_END = WS_KF + (size_t)256 * 3 * 16384 * 8;

struct Params { const float* in[26]; float* out; unsigned char* ws; };
enum { I_XP = 0, I_XS, I_RELB, I_F1N, I_F1GU, I_F1D, I_MIXN, I_WQKV, I_WO, I_HWIN, I_HCW, I_HCB, I_HW1, I_HB1, I_HW2, I_HB2, I_HW3, I_HB3, I_HFREQ, I_HW4, I_HSKIP, I_HWOUT,
       I_F2N, I_F2GU, I_F2D, I_FINN };

DI const float* inp(const Params& p, int i) { asm volatile("" : "+s"(i)); return p.in[i]; }
DI unsigned short f2bf(float f) { unsigned u = __float_as_uint(f); u += 0x7fffu + ((u >> 16) & 1u); return (unsigned short)(u >> 16); }
DI float bf2f(unsigned short b) { return __uint_as_float(((unsigned)b) << 16); }
DI float bflo(unsigned w) { return __uint_as_float(w << 16); }
DI float bfhi(unsigned w) { return __uint_as_float(w & 0xffff0000u); }
DI unsigned pk2(float lo, float hi) { return pg8::cvt_pk_bf16(lo, hi); }

struct EpiSwiGLU {
    static constexpr bool PERM = true, AFTER_DRAIN = false;
    bf16_t* O;
    DI void operator()(const f32x4 (&acc)[2][2][4][2], const pg8::Unit& u, int wr, int wc, int fr, int fq) const {
        const int row0 = u.pm * 256 + wr * 64 + fr, col0 = u.pn * 128 + wc * 32 + 8 * fq;
#pragma unroll
        for (int ai = 0; ai < 2; ++ai)
#pragma unroll
            for (int m = 0; m < 4; ++m) {
                bf16_t* rowp = O + (size_t)(row0 + ai * 128 + m * 16) * FF + col0;
                float hv[8];
#pragma unroll
                for (int n = 0; n < 2; ++n)
#pragma unroll
                    for (int j = 0; j < 4; ++j) { const float g = acc[ai][0][m][n][j], up = acc[ai][1][m][n][j];
                        hv[n * 4 + j] = g * __builtin_amdgcn_rcpf(1.0f + __expf(-g)) * up; }
                u32x4 w; w.x = pk2(hv[0], hv[1]); w.y = pk2(hv[2], hv[3]); w.z = pk2(hv[4], hv[5]); w.w = pk2(hv[6], hv[7]);
                *(u32x4*)rowp = w;
                asm volatile("" ::: "memory");
            }
    }
};
struct EpiBf {
    static constexpr bool PERM = true, AFTER_DRAIN = false;
    bf16_t* O; int ldc;
    DI void operator()(const f32x4 (&acc)[2][2][4][2], const pg8::Unit& u, int wr, int wc, int fr, int fq) const {
        const int row0 = u.pm * 256 + wr * 64 + fr, col0 = u.pn * 256 + wc * 32 + 8 * fq;
#pragma unroll
        for (int ai = 0; ai < 2; ++ai)
#pragma unroll
            for (int m = 0; m < 4; ++m) {
                bf16_t* rowp = O + (size_t)(row0 + ai * 128 + m * 16) * ldc + col0;
#pragma unroll
                for (int bj = 0; bj < 2; ++bj) { const f32x4 v0 = acc[ai][bj][m][0], v1 = acc[ai][bj][m][1];
                    u32x4 w; w.x = pk2(v0[0], v0[1]); w.y = pk2(v0[2], v0[3]); w.z = pk2(v1[0], v1[1]); w.w = pk2(v1[2], v1[3]);
                    *(u32x4*)(rowp + bj * 128) = w; }
            }
    }
};
struct EpiRes {
    static constexpr bool PERM = false, AFTER_DRAIN = false;
    const float* base; float* out; float scale;
    DI void operator()(const f32x4 (&acc)[2][2][4][2], const pg8::Unit& u, int wr, int wc, int fr, int fq) const {
        const int row0 = u.pm * 256 + wr * 64 + fr, col0 = u.pn * 256 + wc * 32 + 4 * fq;
#pragma unroll
        for (int ai = 0; ai < 2; ++ai)
#pragma unroll
            for (int m = 0; m < 4; ++m) { const size_t off = (size_t)(row0 + ai * 128 + m * 16) * DM + col0;
#pragma unroll
                for (int bj = 0; bj < 2; ++bj)
#pragma unroll
                    for (int n = 0; n < 2; ++n) { const f32x4 b = *(const f32x4*)(base + off + bj * 128 + n * 16);
                        *(f32x4*)(out + off + bj * 128 + n * 16) = b + acc[ai][bj][m][n] * scale; }
                asm volatile("" ::: "memory");
            }
    }
};

template <int MODE>
DI void convert_wt(const float* __restrict__ W, bf16_t* __restrict__ Bt, int K, int N, float* ldsf, const int tid) {
    const int ntn = N / 64, ntiles = (K / 64) * ntn;
    for (int tile = blockIdx.x; tile < ntiles; tile += gridDim.x) {
        const int k0 = (tile / ntn) * 64, n0 = (tile % ntn) * 64;
#pragma unroll
        for (int i = 0; i < 8; ++i) { const int idx = tid + NTHR * i, k = idx >> 6, n = idx & 63; ldsf[k * 65 + n] = W[(size_t)(k0 + k) * N + n0 + n]; }
        __syncthreads();
        { const int n = tid >> 3, ks = tid & 7, ncol = n0 + n; int dst = ncol; float sc = 1.0f;
          if (MODE == 1) { if (ncol < FF) dst = 256 * (ncol >> 7) + (ncol & 127); else { const int j = ncol - FF; dst = 256 * (j >> 7) + 128 + (j & 127); } }
          if (MODE == 2) { if ((ncol % 3072) < 1024) sc = 0.125f; }
          float v[8];
#pragma unroll
          for (int j = 0; j < 8; ++j) v[j] = ldsf[(ks * 8 + j) * 65 + n] * sc;
          u32x4 w; w.x = pk2(v[0], v[1]); w.y = pk2(v[2], v[3]); w.z = pk2(v[4], v[5]); w.w = pk2(v[6], v[7]);
          *(u32x4*)(Bt + (size_t)dst * K + k0 + ks * 8) = w; }
        __syncthreads();
    }
}

DI int t5_bucket(int rel) {
    const int n = rel < 0 ? -rel : rel; int ret = rel > 0 ? 16 : 0; int v;
    if (n < 8) v = n;
    else { int k = 0; k += (n >= 15); k += (n >= 27); k += (n >= 50); k += (n >= 91); k += (n >= 166); k += (n >= 305); k += (n >= 559); k += (n >= 1024); v = 8 + k; if (v > 15) v = 15; }
    return ret + v;
}

DI void prologue_small(const Params& p, const int tid) {
    const int lane = tid & 63, wave = tid >> 6;
    unsigned char* ws = p.ws;
    { float2* TW = (float2*)(ws + WS_TW);
      for (int k = blockIdx.x * NTHR + tid; k < 8192; k += gridDim.x * NTHR) { float s, c; sincospif((float)k * (1.0f / 8192.0f), &s, &c); TW[k] = make_float2(c, -s); } }
    { float* BT = (float*)(ws + WS_BIAS); const float* rb = inp(p, I_RELB);
      for (int i = blockIdx.x * NTHR + tid; i < 48 * 132; i += gridDim.x * NTHR) { const int gh = i / 132, dd = i % 132, g = gh >> 4; const int d = g == 0 ? 1 : (g == 1 ? 4 : 16);
          float v = 0.f; if (dd <= 128) v = rb[t5_bucket((dd - 64) * d) * 48 + gh]; BT[i] = v; } }
    { float* H3 = (float*)(ws + WS_H3);
      const float* w1 = inp(p, I_HW1); const float* b1 = inp(p, I_HB1); const float* w2 = inp(p, I_HW2); const float* b2 = inp(p, I_HB2);
      const float* w3 = inp(p, I_HW3); const float* b3 = inp(p, I_HB3); const float* fq = inp(p, I_HFREQ);
      const float fr = fq[lane];
      for (int pos = blockIdx.x * 8 + wave; pos < 10240; pos += gridDim.x * 8) {
          const int L = pos < 2048 ? 2048 : 8192, t = pos < 2048 ? pos : pos - 2048;
          float feat = 0.f;
          if (lane == 0) feat = (float)t / (float)(L - 1);
          else if (lane < 33) { const int b = (lane - 1) & 15; const double frq = 1e-4 + (15.0 - 1e-4) * (double)b / 15.0; double rev = frq * (double)t / (double)L; rev -= floor(rev);
              float s, c; sincospif((float)(2.0 * rev), &s, &c); feat = lane < 17 ? c : -s; }
          float a = b1[lane];
          for (int i = 0; i < 33; ++i) a += __shfl(feat, i) * w1[i * 64 + lane];
          float h = sinf(fr * a);
          a = b2[lane];
          for (int i = 0; i < 64; ++i) a += __shfl(h, i) * w2[i * 64 + lane];
          h = sinf(fr * a);
          a = b3[lane];
          for (int i = 0; i < 64; ++i) a += __shfl(h, i) * w3[i * 64 + lane];
          h = sinf(fr * a);
          H3[(size_t)pos * 64 + lane] = h;
      } }
}

template <bool FINAL>
DI void norm_phase(const float* x, const float* g, bf16_t* xn, float* outf, int M, const int tid) {
    const int lane = tid & 63, gw = blockIdx.x * 8 + (tid >> 6), nw = gridDim.x * 8;
    f32x4 gv[4];
#pragma unroll
    for (int i = 0; i < 4; ++i) gv[i] = ((const f32x4*)g)[lane + 64 * i];
    for (int r = gw; r < M; r += nw) {
        const f32x4* xr = (const f32x4*)(x + (size_t)r * DM);
        f32x4 v[4]; float ss = 0.f;
#pragma unroll
        for (int i = 0; i < 4; ++i) { v[i] = xr[lane + 64 * i]; ss += v[i][0] * v[i][0] + v[i][1] * v[i][1] + v[i][2] * v[i][2] + v[i][3] * v[i][3]; }
#pragma unroll
        for (int o = 32; o >= 1; o >>= 1) ss += __shfl_xor(ss, o);
        const float rs = rsqrtf(ss * (1.0f / 1024.0f) + 1e-6f);
#pragma unroll
        for (int i = 0; i < 4; ++i) { const f32x4 y = v[i] * rs * gv[i];
            if (FINAL) ((f32x4*)(outf + (size_t)r * DM))[lane + 64 * i] = y;
            else { u32x2 w; w.x = pk2(y[0], y[1]); w.y = pk2(y[2], y[3]); *(u32x2*)(xn + (size_t)r * DM + 4 * (lane + 64 * i)) = w; } }
    }
}

DI int crow(int reg, int h) { return (reg & 3) + 8 * (reg >> 2) + 4 * h; }
DI bf16x8 pack8(float a0, float a1, float a2, float a3, float a4, float a5, float a6, float a7) {
    u32x4 p;
    asm volatile("v_cvt_pk_bf16_f32 %0, %4, %5\n\tv_cvt_pk_bf16_f32 %1, %6, %7\n\tv_cvt_pk_bf16_f32 %2, %8, %9\n\tv_cvt_pk_bf16_f32 %3, %10, %11\n\ts_nop 1"
                 : "=&v"(p[0]), "=&v"(p[1]), "=&v"(p[2]), "=&v"(p[3]) : "v"(a0), "v"(a1), "v"(a2), "v"(a3), "v"(a4), "v"(a5), "v"(a6), "v"(a7));
    return __builtin_bit_cast(bf16x8, p);
}
DI s16x4 tr_read(unsigned lds_addr) { s16x4 r; asm volatile("ds_read_b64_tr_b16 %0, %1\n\ts_waitcnt lgkmcnt(0)" : "=&v"(r) : "v"(lds_addr) : "memory"); return r; }
#define MFMA32(a, b, c) __builtin_amdgcn_mfma_f32_32x32x16_bf16((a), (b), (c), 0, 0, 0)

constexpr int VIMG_RS = 144, VIMG_BYTES = 32 * VIMG_RS, ATT_BIAS_OFF = 8 * VIMG_BYTES;

DI void attn_phase(const bf16_t* __restrict__ QKV, bf16_t* __restrict__ OG, float* __restrict__ LSE, const float* __restrict__ biasG, unsigned char* lds, int nseq, int S, const int tid) {
    const int lane = tid & 63, wave = tid >> 6;
    float* ldsb = (float*)(lds + ATT_BIAS_OFF);
    for (int i = tid; i < 48 * 132; i += NTHR) ldsb[i] = biasG[i];
    __syncthreads();
    unsigned char* img = lds + wave * VIMG_BYTES;
    const unsigned imgaddr = (unsigned)(size_t)img;
    const int r = lane & 31, h = lane >> 5;
    const int i16 = lane & 15, tq_ = i16 >> 2, tp_ = i16 & 3, blk = (lane >> 4) & 1;
    const int tiles_per = S / 32;
    const int nunits = nseq * 3 * 16 * tiles_per;
    for (int u = blockIdx.x * 8 + wave; u < nunits; u += gridDim.x * 8) {
        const int tile_lin = u % tiles_per; int rest = u / tiles_per; const int head = rest & 15; rest >>= 4; const int g = rest % 3, seq = rest / 3;
        const int dsh = 2 * g, d = 1 << dsh, lc = S >> dsh, tpc = lc >> 5;
        const int cls = tile_lin / tpc, tile = tile_lin % tpc;
        const int q0 = tile * 32, qc = q0 + r;
        const size_t seqrow = (size_t)seq * S;
        const size_t tq = seqrow + (size_t)qc * d + cls;
        const int colq = g * 3072 + head * 64;
        const bf16_t* qp = QKV + tq * NQKV + colq + 8 * h;
        bf16x8 bq[4];
#pragma unroll
        for (int s = 0; s < 4; ++s) bq[s] = *(const bf16x8*)(qp + 16 * s);
        f32x16 sacc[5];
        bf16x8 kf[2][4];
        { const int kc = q0 - 64 + r; const bool valid = (kc >= 0) && (kc < lc); const int kcc = valid ? kc : qc;
          const bf16_t* kp = QKV + (seqrow + (size_t)kcc * d + cls) * NQKV + colq + 1024 + 8 * h;
#pragma unroll
          for (int s = 0; s < 4; ++s) kf[0][s] = *(const bf16x8*)(kp + 16 * s); }
#pragma unroll
        for (int kt = 0; kt < 5; ++kt) {
            if (kt < 4) { const int kc = q0 - 64 + 32 * (kt + 1) + r; const bool valid = (kc >= 0) && (kc < lc); const int kcc = valid ? kc : qc;
                const bf16_t* kp = QKV + (seqrow + (size_t)kcc * d + cls) * NQKV + colq + 1024 + 8 * h;
#pragma unroll
                for (int s = 0; s < 4; ++s) kf[(kt + 1) & 1][s] = *(const bf16x8*)(kp + 16 * s); }
            f32x16 a;
#pragma unroll
            for (int i = 0; i < 16; ++i) a[i] = 0.f;
#pragma unroll
            for (int s = 0; s < 4; ++s) a = MFMA32(kf[kt & 1][s], bq[s], a);
            sacc[kt] = a;
            asm volatile("" ::: "memory");
        }
        const float* bt = ldsb + (g * 16 + head) * 132;
        float mx = -1e30f;
#pragma unroll
        for (int kt = 0; kt < 5; ++kt)
#pragma unroll
            for (int i = 0; i < 16; ++i) {
                const int krow = 32 * kt + crow(i, h), delta = krow - 64 - r, kci = q0 + krow - 64;
                const bool ok = (delta >= -64) && (delta <= 64) && (kci >= 0) && (kci < lc);
                int bi = delta + 64; bi = bi < 0 ? 0 : (bi > 128 ? 128 : bi);
                const float sv = ok ? sacc[kt][i] + bt[bi] : -1e30f;
                sacc[kt][i] = sv; mx = fmaxf(mx, sv);
            }
        mx = fmaxf(mx, __shfl_xor(mx, 32));
        float l = 0.f;
#pragma unroll
        for (int kt = 0; kt < 5; ++kt)
#pragma unroll
            for (int i = 0; i < 16; ++i) { const float pv = __expf(sacc[kt][i] - mx); sacc[kt][i] = pv; l += pv; }
        l += __shfl_xor(l, 32);
        bf16x8 pfr[5][2];
#pragma unroll
        for (int kt = 0; kt < 5; ++kt)
#pragma unroll
            for (int s = 0; s < 2; ++s)
                pfr[kt][s] = pack8(sacc[kt][8 * s], sacc[kt][8 * s + 1], sacc[kt][8 * s + 2], sacc[kt][8 * s + 3], sacc[kt][8 * s + 4], sacc[kt][8 * s + 5], sacc[kt][8 * s + 6], sacc[kt][8 * s + 7]);
        asm volatile("" ::: "memory");
        f32x16 oacc[2];
#pragma unroll
        for (int i = 0; i < 16; ++i) { oacc[0][i] = 0.f; oacc[1][i] = 0.f; }
        u32x4 vst[2][4];
#pragma unroll
        for (int i = 0; i < 4; ++i) { const int pid = lane + 64 * i, row = pid >> 3, c16 = pid & 7; const int kc = q0 - 64 + row; const bool valid = (kc >= 0) && (kc < lc);
            vst[0][i] = (u32x4){0u, 0u, 0u, 0u};
            if (valid) vst[0][i] = *(const u32x4*)(QKV + (seqrow + (size_t)kc * d + cls) * NQKV + colq + 2048 + c16 * 8); }
#pragma unroll
        for (int kt = 0; kt < 5; ++kt) {
            if (kt < 4) {
#pragma unroll
                for (int i = 0; i < 4; ++i) { const int pid = lane + 64 * i, row = pid >> 3, c16 = pid & 7; const int kc = q0 - 64 + 32 * (kt + 1) + row; const bool valid = (kc >= 0) && (kc < lc);
                    vst[(kt + 1) & 1][i] = (u32x4){0u, 0u, 0u, 0u};
                    if (valid) vst[(kt + 1) & 1][i] = *(const u32x4*)(QKV + (seqrow + (size_t)kc * d + cls) * NQKV + colq + 2048 + c16 * 8); } }
#pragma unroll
            for (int i = 0; i < 4; ++i) { const int pid = lane + 64 * i, row = pid >> 3, c16 = pid & 7; *(u32x4*)(img + row * VIMG_RS + c16 * 16) = vst[kt & 1][i]; }
            asm volatile("s_waitcnt lgkmcnt(0)" ::: "memory");
#pragma unroll
            for (int s = 0; s < 2; ++s) {
                const bf16x8 pf = pfr[kt][s];
#pragma unroll
                for (int et = 0; et < 2; ++et) {
                    const s16x4 lo = tr_read(imgaddr + (16 * s + 4 * h + tq_) * VIMG_RS + (et * 32 + 16 * blk) * 2 + 8 * tp_);
                    const s16x4 hi = tr_read(imgaddr + (16 * s + 8 + 4 * h + tq_) * VIMG_RS + (et * 32 + 16 * blk) * 2 + 8 * tp_);
                    const bf16x8 vf = __builtin_shufflevector(lo, hi, 0, 1, 2, 3, 4, 5, 6, 7);
                    oacc[et] = MFMA32(vf, pf, oacc[et]);
                }
            }
            asm volatile("" ::: "memory");
        }
        const float inv = 1.0f / l, lse = mx + __logf(l);
        bf16_t* op = OG + tq * 3072 + g * 1024 + head * 64;
#pragma unroll
        for (int et = 0; et < 2; ++et)
#pragma unroll
            for (int gq = 0; gq < 4; ++gq) { u32x2 w; w.x = pk2(oacc[et][4 * gq] * inv, oacc[et][4 * gq + 1] * inv); w.y = pk2(oacc[et][4 * gq + 2] * inv, oacc[et][4 * gq + 3] * inv);
                *(u32x2*)(op + et * 32 + 8 * gq + 4 * h) = w; }
        if (h == 0) LSE[tq * 48 + g * 16 + head] = lse;
    }
    __syncthreads();
}

DI void merge_phase(const bf16_t* __restrict__ OG, const float* __restrict__ LSE, bf16_t* __restrict__ ATT, const int tid) {
    const int total = CT * 128;
    for (int idx = blockIdx.x * NTHR + tid; idx < total; idx += gridDim.x * NTHR) {
        const int tok = idx >> 7, c8 = idx & 127, head = c8 >> 3;
        const float l0 = LSE[tok * 48 + head], l1 = LSE[tok * 48 + 16 + head], l2 = LSE[tok * 48 + 32 + head];
        const float m = fmaxf(l0, fmaxf(l1, l2));
        float a0 = __expf(l0 - m), a1 = __expf(l1 - m), a2 = __expf(l2 - m); const float inv = 1.0f / (a0 + a1 + a2); a0 *= inv; a1 *= inv; a2 *= inv;
        const u32x4 o0 = *(const u32x4*)(OG + (size_t)tok * 3072 + c8 * 8), o1 = *(const u32x4*)(OG + (size_t)tok * 3072 + 1024 + c8 * 8), o2 = *(const u32x4*)(OG + (size_t)tok * 3072 + 2048 + c8 * 8);
        u32x4 w;
#pragma unroll
        for (int j = 0; j < 4; ++j) { const float lo = a0 * bflo(o0[j]) + a1 * bflo(o1[j]) + a2 * bflo(o2[j]); const float hi = a0 * bfhi(o0[j]) + a1 * bfhi(o1[j]) + a2 * bfhi(o2[j]); w[j] = pk2(lo, hi); }
        *(u32x4*)(ATT + (size_t)tok * 1024 + c8 * 8) = w;
    }
}

DI void tconv_phase(const bf16_t* __restrict__ U, const float* __restrict__ cw, const float* __restrict__ cb, bf16_t* __restrict__ UT, unsigned char* lds, int nseq, int L, const int tid) {
    const int tt = L / 64, ntiles = nseq * tt * 48;
    for (int tile = blockIdx.x; tile < ntiles; tile += gridDim.x) {
        const int ct = tile % 48; int rest = tile / 48; const int ti = rest % tt, seq = rest / tt; const int ch0 = ct * 64, t0 = ti * 64;
        for (int pid = tid; pid < 66 * 8; pid += NTHR) { const int row = pid >> 3, c16 = pid & 7, t = t0 - 1 + row; u32x4 val = (u32x4){0u, 0u, 0u, 0u};
            if (t >= 0 && t < L) val = *(const u32x4*)(U + ((size_t)seq * L + t) * 3072 + ch0 + c16 * 8);
            *(u32x4*)(lds + row * 144 + c16 * 16) = val; }
        __syncthreads();
        { const int ch = tid & 63, tg = tid >> 6; const float w0 = cw[ch0 + ch], w1 = cw[3072 + ch0 + ch], w2 = cw[6144 + ch0 + ch], b = cb[ch0 + ch];
          float xv[10];
#pragma unroll
          for (int j = 0; j < 10; ++j) xv[j] = bf2f(*(const bf16_t*)(lds + (tg * 8 + j) * 144 + ch * 2));
          float o[8];
#pragma unroll
          for (int j = 0; j < 8; ++j) o[j] = xv[j] * w0 + xv[j + 1] * w1 + xv[j + 2] * w2 + b;
          u32x4 w; w.x = pk2(o[0], o[1]); w.y = pk2(o[2], o[3]); w.z = pk2(o[4], o[5]); w.w = pk2(o[6], o[7]);
          *(u32x4*)(UT + ((size_t)seq * 3072 + ch0 + ch) * L + t0 + tg * 8) = w; }
        __syncthreads();
    }
}
DI void ztrans_phase(const bf16_t* __restrict__ ZT, bf16_t* __restrict__ ZR, unsigned char* lds, int nseq, int L, const int tid) {
    const int tt = L / 64, ntiles = nseq * tt * 16;
    for (int tile = blockIdx.x; tile < ntiles; tile += gridDim.x) {
        const int ct = tile % 16; int rest = tile / 16; const int ti = rest % tt, seq = rest / tt; const int ch0 = ct * 64, t0 = ti * 64;
        { const int row = tid >> 3, c16 = tid & 7; *(u32x4*)(lds + row * 144 + c16 * 16) = *(const u32x4*)(ZT + ((size_t)seq * 1024 + ch0 + row) * L + t0 + c16 * 8); }
        __syncthreads();
        { const int t = tid & 63, cgp = tid >> 6; unsigned short v[8];
#pragma unroll
          for (int j = 0; j < 8; ++j) v[j] = *(const bf16_t*)(lds + (cgp * 8 + j) * 144 + t * 2);
          u32x4 w; w.x = v[0] | ((unsigned)v[1] << 16); w.y = v[2] | ((unsigned)v[3] << 16); w.z = v[4] | ((unsigned)v[5] << 16); w.w = v[6] | ((unsigned)v[7] << 16);
          *(u32x4*)(ZR + ((size_t)seq * L + t0 + t) * 1024 + ch0 + cgp * 8) = w; }
        __syncthreads();
    }
}

DI float2 cmul(float2 a, float2 b) { return make_float2(a.x * b.x - a.y * b.y, a.x * b.y + a.y * b.x); }
template <int R, bool INV, int LOG2N>
DI void fft_pass(float2* buf, const float2* __restrict__ TW, int s, const int tid) {
    constexpr int N = 1 << LOG2N, NP = 1 << R;
    const int lmp = LOG2N - s - R, mp = 1 << lmp;
#pragma unroll 1
    for (int w = tid; w < (N >> R); w += NTHR) {
        const int jp = w & (mp - 1), blk = w >> lmp, base = (blk << (lmp + R)) + jp;
        float2 v[NP];
#pragma unroll
        for (int q = 0; q < NP; ++q) v[q] = buf[base + q * mp];
        if (!INV) {
#pragma unroll
            for (int u = 0; u < R; ++u) { const int hq = 1 << (R - 1 - u), lmu = lmp + R - 1 - u;
#pragma unroll
                for (int q = 0; q < NP; ++q) if (!(q & hq)) { const int ju = jp + (q & (hq - 1)) * mp; const float2 tw = TW[ju << (13 - lmu)];
                    const float2 a = v[q], b = v[q + hq]; v[q] = make_float2(a.x + b.x, a.y + b.y); v[q + hq] = cmul(make_float2(a.x - b.x, a.y - b.y), tw); } }
        } else {
#pragma unroll
            for (int u = R - 1; u >= 0; --u) { const int hq = 1 << (R - 1 - u), lmu = lmp + R - 1 - u;
#pragma unroll
                for (int q = 0; q < NP; ++q) if (!(q & hq)) { const int ju = jp + (q & (hq - 1)) * mp; float2 tw = TW[ju << (13 - lmu)]; tw.y = -tw.y;
                    const float2 a = v[q], b = cmul(v[q + hq], tw); v[q] = make_float2(a.x + b.x, a.y + b.y); v[q + hq] = make_float2(a.x - b.x, a.y - b.y); } }
        }
#pragma unroll
        for (int q = 0; q < NP; ++q) buf[base + q * mp] = v[q];
    }
    __syncthreads();
}
template <int LOG2N> DI void fft_fwd(float2* buf, const float2* TW, const int tid) {
    fft_pass<3, false, LOG2N>(buf, TW, 0, tid); fft_pass<3, false, LOG2N>(buf, TW, 3, tid); fft_pass<3, false, LOG2N>(buf, TW, 6, tid); fft_pass<3, false, LOG2N>(buf, TW, 9, tid);
    if (LOG2N == 14) fft_pass<2, false, LOG2N>(buf, TW, 12, tid);
}
template <int LOG2N> DI void fft_inv(float2* buf, const float2* TW, const int tid) {
    if (LOG2N == 14) fft_pass<2, true, LOG2N>(buf, TW, 12, tid);
    fft_pass<3, true, LOG2N>(buf, TW, 9, tid); fft_pass<3, true, LOG2N>(buf, TW, 6, tid); fft_pass<3, true, LOG2N>(buf, TW, 3, tid); fft_pass<3, true, LOG2N>(buf, TW, 0, tid);
}
DI float2 ld_agent_f2(const float2* p) { const unsigned long long w = __hip_atomic_load((const unsigned long long*)p, __ATOMIC_RELAXED, __HIP_MEMORY_SCOPE_AGENT);
    return make_float2(__uint_as_float((unsigned)w), __uint_as_float((unsigned)(w >> 32))); }

template <int LOG2N>
DI void hyena_fft_phase(const bf16_t* __restrict__ UT, bf16_t* __restrict__ ZT, const float* __restrict__ H3, const float* __restrict__ w4, const float* __restrict__ skip,
                        const float2* __restrict__ TW, float2* KF, unsigned char* lds, int nseq, const int tid) {
    constexpr int N = 1 << LOG2N, L = N / 2, PT = L / NTHR;
    float2* buf = (float2*)lds; float* w4s = (float*)(lds + 131072); float2* Z1 = KF + 2 * 16384;
    const float invN = 1.0f / (float)N;
    for (int ch = blockIdx.x; ch < DM; ch += gridDim.x) {
        if (tid < 256) { const int j = tid >> 2, q = tid & 3; w4s[tid] = w4[(size_t)j * 4096 + q * 1024 + ch]; }
        __syncthreads();
        const float mind = -3.0701134573253945f, maxd = -15.350567286626972f;
        const float adelta = fabsf(mind + (maxd - mind) * ((float)ch / 1023.0f));
        const float sk0 = skip[ch], sk1 = skip[1024 + ch];
#pragma unroll 1
        for (int o = 0; o < 2; ++o) {
#pragma unroll 1
            for (int i = 0; i < PT; ++i) { const int t = tid + NTHR * i; const f32x4* hp = (const f32x4*)(H3 + (size_t)t * 64); float f = 0.f, b = 0.f;
                int zo = o * 2; asm volatile("" : "+v"(zo));
                const float2* wq = (const float2*)(w4s + zo);
#pragma unroll 4
                for (int j4 = 0; j4 < 16; ++j4) { const f32x4 hv = hp[j4];
#pragma unroll
                    for (int jj = 0; jj < 4; ++jj) { const float2 wv = wq[(j4 * 4 + jj) * 2]; f += hv[jj] * wv.x; b += hv[jj] * wv.y; } }
                const float dec = __expf(-((float)t / (float)(L - 1)) * adelta); f *= dec; b *= dec;
                buf[t] = make_float2(f, 0.f); if (t == 0) buf[L] = make_float2(0.f, 0.f); else buf[N - t] = make_float2(b, 0.f); }
            __syncthreads();
            fft_fwd<LOG2N>(buf, TW, tid);
#pragma unroll 1
            for (int i = 0; i < 2 * PT; ++i) { const int idx = tid + NTHR * i; KF[(size_t)o * N + idx] = buf[idx]; }
            __syncthreads();
        }
        __threadfence();
        __syncthreads();
        for (int pr = 0; pr < nseq / 2; ++pr) {
            const size_t sa = (size_t)(2 * pr), sb = sa + 1;
            const bf16_t* zpa = UT + (sa * 3072 + 2048 + ch) * L; const bf16_t* zpb = UT + (sb * 3072 + 2048 + ch) * L;
#pragma unroll 2
            for (int i = 0; i < PT; ++i) { const int t = tid + NTHR * i; buf[t] = make_float2(bf2f(zpa[t]), bf2f(zpb[t])); buf[t + L] = make_float2(0.f, 0.f); }
#pragma unroll 1
            for (int o = 0; o < 2; ++o) {
                __syncthreads();
                fft_fwd<LOG2N>(buf, TW, tid);
#pragma unroll 2
                for (int i = 0; i < 2 * PT; ++i) { const int idx = tid + NTHR * i; buf[idx] = cmul(buf[idx], ld_agent_f2(KF + (size_t)o * N + idx)); }
                __syncthreads();
                fft_inv<LOG2N>(buf, TW, tid);
                const float sk = o == 0 ? sk0 : sk1;
                const bf16_t* xpa = UT + (sa * 3072 + o * 1024 + ch) * L; const bf16_t* xpb = UT + (sb * 3072 + o * 1024 + ch) * L;
                bf16_t* opa = ZT + (sa * 1024 + ch) * L; bf16_t* opb = ZT + (sb * 1024 + ch) * L;
#pragma unroll 2
                for (int i = 0; i < PT; ++i) { const int t = tid + NTHR * i; const float2 c = buf[t];
                    float2 zp; if (o == 0) zp = make_float2(bf2f(zpa[t]), bf2f(zpb[t])); else zp = Z1[t];
                    const float na = bf2f(xpa[t]) * (c.x * invN + zp.x * sk), nb = bf2f(xpb[t]) * (c.y * invN + zp.y * sk);
                    if (o == 0) { Z1[t] = make_float2(na, nb); buf[t] = make_float2(na, nb); buf[t + L] = make_float2(0.f, 0.f); }
                    else { opa[t] = f2bf(na); opb[t] = f2bf(nb); } }
            }
            __syncthreads();
        }
    }
}

__global__ void __launch_bounds__(NTHR) fwd_megakernel(Params p) {
    extern __shared__ __attribute__((aligned(16))) unsigned char lds[];
    cg::grid_group grid = cg::this_grid();
    unsigned char* ws = p.ws;
    LAS unsigned char* ldsl = (LAS unsigned char*)lds;
    const int G = gridDim.x, bx = blockIdx.x;
    int tid = threadIdx.x; asm volatile("" : "+v"(tid));

    for (int li = 0; li < 2; ++li) {
        convert_wt<1>(inp(p, I_F1GU) + (size_t)li * 1024 * 5632, (bf16_t*)(ws + WS_WGU + (size_t)li * SZ_WGU), 1024, 5632, (float*)lds, tid);
        convert_wt<1>(inp(p, I_F2GU) + (size_t)li * 1024 * 5632, (bf16_t*)(ws + WS_WGU + (size_t)(2 + li) * SZ_WGU), 1024, 5632, (float*)lds, tid);
        convert_wt<0>(inp(p, I_F1D) + (size_t)li * 2816 * 1024, (bf16_t*)(ws + WS_WDN + (size_t)li * SZ_WDN), 2816, 1024, (float*)lds, tid);
        convert_wt<0>(inp(p, I_F2D) + (size_t)li * 2816 * 1024, (bf16_t*)(ws + WS_WDN + (size_t)(2 + li) * SZ_WDN), 2816, 1024, (float*)lds, tid);
    }
    convert_wt<2>(inp(p, I_WQKV), (bf16_t*)(ws + WS_WQKV), 1024, 9216, (float*)lds, tid);
    for (int li = 0; li < 3; ++li) {
        const float* W = li == 0 ? inp(p, I_WO) : (li == 1 ? inp(p, I_HWIN) : inp(p, I_HWOUT));
        bf16_t* Bt = (bf16_t*)(ws + (li == 0 ? WS_WO : (li == 1 ? WS_WIN : WS_WOUT)));
        convert_wt<0>(W, Bt, 1024, li == 1 ? 3072 : 1024, (float*)lds, tid);
    }
    prologue_small(p, tid);
    grid.sync();

    bf16_t* XN = (bf16_t*)(ws + WS_XN); bf16_t* HB = (bf16_t*)(ws + WS_H); bf16_t* ATT = (bf16_t*)(ws + WS_ATT); float* LSE = (float*)(ws + WS_LSE);
    bf16_t* OG = (bf16_t*)(ws + WS_OG); bf16_t* BIG = (bf16_t*)(ws + WS_BIG); bf16_t* UT = (bf16_t*)(ws + WS_BIG + SZ_U);
    const float2* TW = (const float2*)(ws + WS_TW);

    for (int c = 0; c < NCHUNK; ++c) {
        const bool samp = (c == NCHUNK - 1);
        const float* xin = samp ? inp(p, I_XS) : inp(p, I_XP) + (size_t)c * CT * DM;
        float* xo = p.out + (size_t)c * CT * DM;
        const int S = samp ? 8192 : 2048, nseq = samp ? 2 : 8;
#pragma unroll 1
        for (int ph = 0; ph < NPH; ++ph) {
            tid = threadIdx.x; asm volatile("" : "+v"(tid));
            int kind = 0, widx = 0;
            switch (ph) {
                case 0: kind = 0; break;  case 1: kind = 1; widx = 0; break;  case 2: kind = 2; widx = 0; break;
                case 3: kind = 0; break;  case 4: kind = 3; break;  case 5: kind = 4; break;  case 6: kind = 5; break;  case 7: kind = 2; widx = 4; break;
                case 8: kind = 0; break;  case 9: kind = 1; widx = 2; break;  case 10: kind = 2; widx = 2; break;
                case 11: kind = 0; break; case 12: kind = 1; widx = 1; break; case 13: kind = 2; widx = 1; break;
                case 14: kind = 0; break; case 15: kind = 3; break; case 16: kind = 6; break; case 17: kind = 7; break; case 18: kind = 8; break; case 19: kind = 2; widx = 5; break;
                case 20: kind = 0; break; case 21: kind = 1; widx = 3; break; case 22: kind = 2; widx = 3; break;
                default: kind = 9; break;
            }
            if (kind == 0) {
                const float* src = ph == 0 ? xin : xo; const float* g;
                if (ph == 0) g = inp(p, I_F1N); else if (ph == 3) g = inp(p, I_MIXN); else if (ph == 8) g = inp(p, I_F2N); else if (ph == 11) g = inp(p, I_F1N) + DM; else if (ph == 14) g = inp(p, I_MIXN) + DM; else g = inp(p, I_F2N) + DM;
                norm_phase<false>(src, g, XN, nullptr, CT, tid);
            } else if (kind == 9) {
                norm_phase<true>(xo, inp(p, I_FINN), nullptr, xo, CT, tid);
            } else if (kind == 1) {
                pg8::Gemm gm{XN, (const bf16_t*)(ws + WS_WGU + (size_t)widx * SZ_WGU), CT, 5632, 1024}; pg8::StaticOrder so; so.init(CT, 5632, G, bx);
                EpiSwiGLU E{HB};
#ifndef NO_G1
                pg8::gemm_phase<EpiSwiGLU, pg8::StaticOrder, false>(ldsl, gm, so, E, nullptr, tid);
#endif
            } else if (kind == 2) {
                pg8::Gemm gm; float scale = 0.5f; const float* base = (ph == 2) ? xin : xo;
                if (widx < 4) { gm = pg8::Gemm{HB, (const bf16_t*)(ws + WS_WDN + (size_t)widx * SZ_WDN), CT, 1024, 2816}; }
                else { gm = pg8::Gemm{ATT, (const bf16_t*)(ws + (widx == 4 ? WS_WO : WS_WOUT)), CT, 1024, 1024}; scale = 1.0f; }
                pg8::StaticOrder so; so.init(CT, 1024, G, bx);
                EpiRes E{base, xo, scale};
#ifndef NO_G2
                pg8::gemm_phase<EpiRes, pg8::StaticOrder, false>(ldsl, gm, so, E, nullptr, tid);
#endif
            } else if (kind == 3) {
                const int Nn = ph == 4 ? NQKV : 3072;
                pg8::Gemm gm{XN, (const bf16_t*)(ws + (ph == 4 ? WS_WQKV : WS_WIN)), CT, Nn, 1024}; pg8::StaticOrder so; so.init(CT, Nn, G, bx);
                EpiBf E{BIG, Nn};
#ifndef NO_G3
                pg8::gemm_phase<EpiBf, pg8::StaticOrder, false>(ldsl, gm, so, E, nullptr, tid);
#endif
            } else if (kind == 4) {
#ifndef NO_ATT
                attn_phase(BIG, OG, LSE, (const float*)(ws + WS_BIAS), lds, nseq, S, tid);
#endif
            } else if (kind == 5) {
                merge_phase(OG, LSE, ATT, tid);
            } else if (kind == 6) {
                tconv_phase(BIG, inp(p, I_HCW), inp(p, I_HCB), UT, lds, nseq, S, tid);
            } else if (kind == 7) {
                float2* KF = (float2*)(ws + WS_KF) + (size_t)bx * 3 * 16384;
#ifndef NO_FFT
                if (samp) hyena_fft_phase<14>(UT, OG, (const float*)(ws + WS_H3) + (size_t)2048 * 64, inp(p, I_HW4), inp(p, I_HSKIP), TW, KF, lds, nseq, tid);
                else hyena_fft_phase<12>(UT, OG, (const float*)(ws + WS_H3), inp(p, I_HW4), inp(p, I_HSKIP), TW, KF, lds, nseq, tid);
#endif
            } else if (kind == 8) {
                ztrans_phase(OG, ATT, lds, nseq, S, tid);
            }
            if (!(c == NCHUNK - 1 && ph == NPH - 1)) grid.sync();
        }
    }
}

extern "C" void kernel_launch(void* const* d_in, const int* in_sizes, int n_in, void* d_out, int out_size, void* d_ws, size_t ws_size, hipStream_t stream) {
    static int grid_blocks = 0;
    if (grid_blocks == 0) {
        if (n_in != 26 || ws_size < WS_END) { fprintf(stderr, "kernel_launch: need 26 inputs and >= %zu bytes of workspace; got %d, %zu\n", (size_t)WS_END, n_in, ws_size); grid_blocks = -1; return; }
        int dev = 0, cus = 0, per_cu = 0;
        hipGetDevice(&dev);
        hipDeviceGetAttribute(&cus, hipDeviceAttributeMultiprocessorCount, dev);
        if (hipFuncSetAttribute((const void*)fwd_megakernel, hipFuncAttributeMaxDynamicSharedMemorySize, LDS_BYTES) != hipSuccess) { fprintf(stderr, "kernel_launch: hipFuncSetAttribute failed\n"); grid_blocks = -1; return; }
        hipOccupancyMaxActiveBlocksPerMultiprocessor(&per_cu, (const void*)fwd_megakernel, NTHR, LDS_BYTES);
        if (per_cu < 1) { fprintf(stderr, "kernel_launch: occupancy query says %d blocks per CU\n", per_cu); per_cu = 1; }
        (void)hipGetLastError();
        grid_blocks = cus > 256 ? 256 : cus;
    }
    if (grid_blocks < 0) return;
    Params p{};
    for (int i = 0; i < 26; ++i) p.in[i] = (const float*)d_in[i];
    p.out = (float*)d_out; p.ws = (unsigned char*)d_ws;
    void* args[] = {&p};
    hipError_t e = hipLaunchCooperativeKernel((const void*)fwd_megakernel, dim3(grid_blocks), dim3(NTHR), args, LDS_BYTES, stream);
    if (e != hipSuccess) fprintf(stderr, "cooperative launch failed: %s (grid %d)\n", hipGetErrorString(e), grid_blocks);
}
```

```cpp
#include <hip/hip_runtime.h>
#include <hip/hip_cooperative_groups.h>
#include <cstdio>
namespace cg = cooperative_groups;
namespace pg8 {
#define PG8_LAS __attribute__((address_space(3)))
typedef unsigned short bf16_t;
typedef short bf16x8 __attribute__((ext_vector_type(8)));
typedef float f32x4 __attribute__((ext_vector_type(4)));
typedef unsigned u32x4 __attribute__((ext_vector_type(4)));
constexpr int BM = 256, BK = 64, HALF = 128, HTB = HALF * BK * 2  , STAGE_BYTES = 8 * HTB, NXCD = 8, WGM = 8;

__host__ __device__ __forceinline__ int lds_byte(int r, int c) { const int st = (r >> 4) * 2 + (c >> 5), rr = r & 15, cc = c & 31, ob = rr * 64 + cc * 2; return st * 1024 + (ob ^ (((ob >> 9) & 1) << 5)); }
__host__ __device__ __forceinline__ void stage_rc(int b, int& R, int& C) { const int st = b / 1024, sb = b % 1024, swz = sb ^ (((sb >> 9) & 1) << 5); R = (st >> 1) * 16 + swz / 64; C = (st & 1) * 32 + (swz % 64) / 2; }
__host__ __device__ __forceinline__ int perm32(int rho) { const int n = rho >> 4, i = rho & 15; return 8 * (i >> 2) + 4 * n + (i & 3); }

struct Unit { int pm, pn; };
struct Gemm { const bf16_t* A; const bf16_t* Bt; int M, N, K; };

struct StaticOrder {
    int nM, nN, nwg, G, c;
    __host__ __device__ void init(int M, int N, int G_, int c_) { nM = M / BM; nN = N / BM; nwg = nM * nN; G = G_; c = c_; }
    __host__ __device__ bool next(int i, Unit& u) const {
        const long L = (long)i * G + c; if (L >= nwg) return false;
        int wgid = (int)L; { const int q = nwg / NXCD, r = nwg % NXCD, xcd = wgid % NXCD, off = wgid / NXCD; wgid = (xcd < r ? xcd * (q + 1) : r * (q + 1) + (xcd - r) * q) + off; }
        const int nig = WGM * nN, gid = wgid / nig, fm = gid * WGM, gsz = (nM - fm) < WGM ? (nM - fm) : WGM;
        u.pm = fm + ((wgid % nig) % gsz); u.pn = (wgid % nig) / gsz; return true;
    }
    __device__ __forceinline__ void a_ready(const Unit&) const {}
    __device__ __forceinline__ void done(const Unit&) const {}
};
__device__ __forceinline__ unsigned cvt_pk_bf16(float lo, float hi) { unsigned r; asm volatile("v_cvt_pk_bf16_f32 %0, %1, %2" : "=v"(r) : "v"(lo), "v"(hi)); return r; }
typedef float f32x2 __attribute__((ext_vector_type(2)));
__device__ __forceinline__ f32x2 gelu_pk(f32x2 v) {
    const f32x2 av = __builtin_elementwise_abs(v), d = av * 0.2316418882f + 1.0f;
    f32x2 t; t.x = __builtin_amdgcn_rcpf(d.x); t.y = __builtin_amdgcn_rcpf(d.y);
    f32x2 q = t * 0.5307027145f + (-0.7265760135f); q = q * t + 0.7107068705f; q = q * t + (-0.142248368f); q = q * t + 0.127414796f; q = q * t;
    const f32x2 s = (v * v) * (-0.72134752044f);
    f32x2 e; e.x = __builtin_amdgcn_exp2f(s.x); e.y = __builtin_amdgcn_exp2f(s.y);
    const f32x2 m = v * (q * e), r = v - m;
    f32x2 o; o.x = v.x < 0.f ? m.x : r.x; o.y = v.y < 0.f ? m.y : r.y; return o;
}

template <class Epi, class Sched, bool STAMP = false>
__device__ __forceinline__ void gemm_phase(PG8_LAS unsigned char* lds, const Gemm g, const Sched& S, const Epi& E, unsigned long long* stamps, const int tid) {
    const int  wid = __builtin_amdgcn_readfirstlane(tid >> 6), lane = tid & 63, wr = wid >> 2, wc = wid & 3, fr = lane & 15, fq = lane >> 4;
    const int K = g.K, nt = K / BK;
    int ts_lo = 0, ts_hi = 0, nts = 0; const unsigned long long rt_entry = STAMP ? (unsigned long long)wall_clock64() : 0ull;
#define PG8_STAMP() do { if (STAMP && wid == 0 && nts < 64) { const unsigned long long _c = (unsigned long long)clock64(); \
        ts_lo = (lane == nts) ? (int)(unsigned)_c : ts_lo; ts_hi = (lane == nts) ? (int)(unsigned)(_c >> 32) : ts_hi; ++nts; } } while (0)
    PG8_STAMP();
    unsigned voffA[2], voffB[2];
#pragma unroll
    for (int i = 0; i < 2; ++i) { int R, C; stage_rc(tid * 16 + i * 8192, R, C); const int Rb = Epi::PERM ? ((R & ~31) + perm32(R & 31)) : R;
        voffA[i] = (unsigned)(R * K + C) * 2u; voffB[i] = (unsigned)(Rb * K + C) * 2u; }
    const size_t kstep = (size_t)(BK * 2);
    const size_t hstep = (size_t)HALF * K * 2;
    const size_t tstep = 2 * hstep;
    const unsigned ldsw = (unsigned)wid * 1024u;
    const int aoff = lds_byte(wr * 64 + fr, fq * 8), boff = lds_byte(wc * 32 + fr, fq * 8);
#define PG8_SA(b, h) (((b) * 2 + (h)) * HTB)
#define PG8_SB(b, h) ((4 + (b) * 2 + (h)) * HTB)
#define PG8_STAGE(bufoff, gbase, voff) do { _Pragma("unroll") for (int _i = 0; _i < 2; ++_i) \
        __builtin_amdgcn_global_load_lds((const unsigned*)((const char*)(gbase) + (voff)[_i]), (PG8_LAS unsigned*)(lds + (bufoff) + ldsw + _i * 8192), 16, 0, 0); } while (0)
#define PG8_LDA(dst, b, h) do { _Pragma("unroll") for (int m = 0; m < 4; ++m) _Pragma("unroll") for (int k = 0; k < 2; ++k) dst[m][k] = *(const PG8_LAS bf16x8*)(lds + PG8_SA(b, h) + aoff + m * 2048 + k * 1024); } while (0)
#define PG8_LDB(dst, b, h) do { _Pragma("unroll") for (int n = 0; n < 2; ++n) _Pragma("unroll") for (int k = 0; k < 2; ++k) dst[n][k] = *(const PG8_LAS bf16x8*)(lds + PG8_SB(b, h) + boff + n * 2048 + k * 1024); } while (0)
#define PG8_MMA(ai, bj, At, Bt) do { __builtin_amdgcn_s_setprio(1); _Pragma("unroll") for (int m = 0; m < 4; ++m) _Pragma("unroll") for (int n = 0; n < 2; ++n) _Pragma("unroll") for (int k = 0; k < 2; ++k) \
        acc[ai][bj][m][n] = __builtin_amdgcn_mfma_f32_16x16x32_bf16(Bt[n][k], At[m][k], acc[ai][bj][m][n], 0, 0, 0); __builtin_amdgcn_s_setprio(0); } while (0)
#define PG8_WAIT_V(n) asm volatile("s_waitcnt vmcnt(" #n ")" ::: "memory")
#define PG8_WAIT_L(n) asm volatile("s_waitcnt lgkmcnt(" #n ")" ::: "memory")
#define PG8_BAR __builtin_amdgcn_s_barrier()
#define PG8_SCHED __builtin_amdgcn_sched_barrier(0)
    Unit cur, nxt; int ui = 0;
    if (!S.next(0, cur)) return;
    f32x4 acc[2][2][4][2];
#pragma unroll
    for (int a = 0; a < 2; ++a)
#pragma unroll
        for (int b = 0; b < 2; ++b)
#pragma unroll
            for (int m = 0; m < 4; ++m)
#pragma unroll
                for (int n = 0; n < 2; ++n) acc[a][b][m][n] = (f32x4){0.f, 0.f, 0.f, 0.f};
    bf16x8 At[4][2], B0[2][2], B1[2][2];
    const char* cA = (const char*)g.A + (size_t)cur.pm * tstep; const char* cB = (const char*)g.Bt + (size_t)cur.pn * tstep;
    S.a_ready(cur);
    PG8_STAGE(PG8_SB(0, 0), cB, voffB); PG8_STAGE(PG8_SA(0, 0), cA, voffA); PG8_STAGE(PG8_SB(0, 1), cB + hstep, voffB); PG8_STAGE(PG8_SA(0, 1), cA + hstep, voffA);
    if (wr == 1) PG8_BAR;
    PG8_WAIT_V(4); PG8_BAR;
    PG8_STAGE(PG8_SB(1, 0), cB + kstep, voffB); PG8_STAGE(PG8_SA(1, 0), cA + kstep, voffA); PG8_STAGE(PG8_SB(1, 1), cB + hstep + kstep, voffB);
    PG8_WAIT_V(6); PG8_BAR;
    PG8_STAMP();
    for (;;) {
        const bool has_next = S.next(ui + 1, nxt);
        const char* nA = has_next ? (const char*)g.A + (size_t)nxt.pm * tstep : cA; const char* nB = has_next ? (const char*)g.Bt + (size_t)nxt.pn * tstep : cB;
#ifdef PROBE_GEMM
        unsigned long long pg_t0 = __builtin_amdgcn_s_memrealtime();
#endif
        for (int t = 0; t < nt; t += 2) {
            const bool last = (t == nt - 2);
            const char* a1 = cA + (size_t)(t + 1) * kstep;
            const char* a2 = last ? nA : cA + (size_t)(t + 2) * kstep; const char* b2 = last ? nB : cB + (size_t)(t + 2) * kstep;
            const char* a3 = a2 + kstep; const char* b3 = b2 + kstep;
            if (last && has_next) S.a_ready(nxt);
            PG8_LDB(B0, 0, 0); PG8_SCHED; PG8_LDA(At, 0, 0); PG8_STAGE(PG8_SA(1, 1), a1 + hstep, voffA);
            PG8_WAIT_L(8); PG8_BAR; PG8_WAIT_L(0); PG8_MMA(0, 0, At, B0); PG8_BAR; PG8_SCHED;
            PG8_LDB(B1, 0, 1); PG8_STAGE(PG8_SB(0, 0), b2, voffB);
            PG8_BAR; PG8_WAIT_L(0); PG8_MMA(0, 1, At, B1); PG8_BAR;
            PG8_LDA(At, 0, 1); PG8_STAGE(PG8_SA(0, 0), a2, voffA);
            PG8_BAR; PG8_WAIT_L(0); PG8_MMA(1, 0, At, B0); PG8_BAR; PG8_SCHED;
            PG8_STAGE(PG8_SB(0, 1), b2 + hstep, voffB);
            PG8_WAIT_V(6); PG8_BAR; PG8_MMA(1, 1, At, B1); PG8_BAR;
            PG8_LDB(B0, 1, 0); PG8_SCHED; PG8_LDA(At, 1, 0); PG8_STAGE(PG8_SA(0, 1), a2 + hstep, voffA);
            PG8_WAIT_L(8); PG8_BAR; PG8_WAIT_L(0); PG8_MMA(0, 0, At, B0); PG8_BAR; PG8_SCHED;
            PG8_LDB(B1, 1, 1); PG8_STAGE(PG8_SB(1, 0), b3, voffB);
            PG8_BAR; PG8_WAIT_L(0); PG8_MMA(0, 1, At, B1); PG8_BAR;
            PG8_LDA(At, 1, 1); PG8_STAGE(PG8_SA(1, 0), a3, voffA);
            PG8_BAR; PG8_WAIT_L(0); PG8_MMA(1, 0, At, B0); PG8_BAR; PG8_SCHED;
            PG8_STAGE(PG8_SB(1, 1), b3 + hstep, voffB);
            PG8_WAIT_V(6); PG8_BAR; PG8_MMA(1, 1, At, B1); PG8_BAR;
        }
        PG8_STAMP();
#ifdef PROBE_GEMM
        { const unsigned long long t1_ = __builtin_amdgcn_s_memrealtime(); if (tid == 0) ((PG8_LAS unsigned long long*)(lds + 147456 + 3072))[12] += t1_ - pg_t0; pg_t0 = t1_; }
#endif
        if constexpr (!Epi::AFTER_DRAIN) { E(acc, cur, wr, wc, fr, fq); S.done(cur); }
#ifdef PROBE_GEMM
        { const unsigned long long t1_ = __builtin_amdgcn_s_memrealtime(); if (tid == 0) ((PG8_LAS unsigned long long*)(lds + 147456 + 3072))[13] += t1_ - pg_t0; pg_t0 = t1_; }
#endif
        PG8_STAMP();
        if (!has_next) break;
#pragma unroll
        for (int a = 0; a < 2; ++a)
#pragma unroll
            for (int b = 0; b < 2; ++b)
#pragma unroll
                for (int m = 0; m < 4; ++m)
#pragma unroll
                    for (int n = 0; n < 2; ++n) acc[a][b][m][n] = (f32x4){0.f, 0.f, 0.f, 0.f};
        cur = nxt; cA = nA; cB = nB; ++ui;
    }
    PG8_WAIT_V(0);
    if (wr == 0) PG8_BAR;
    PG8_BAR;
    if constexpr (Epi::AFTER_DRAIN) { E.fused(acc, cur, wr, wc, fr, fq, lds, wid, lane); S.done(cur); }
    PG8_STAMP();
    if (STAMP && wid == 0) { stamps[lane] = lane < nts ? (((unsigned long long)(unsigned)ts_hi << 32) | (unsigned)ts_lo) : 0ull;
        if (lane == 62) stamps[62] = rt_entry; if (lane == 63) stamps[63] = (unsigned long long)wall_clock64(); }
#undef PG8_STAMP
#undef PG8_SA
#undef PG8_SB
#undef PG8_STAGE
#undef PG8_LDA
#undef PG8_LDB
#undef PG8_MMA
#undef PG8_WAIT_V
#undef PG8_WAIT_L
#undef PG8_BAR
#undef PG8_SCHED
}
}

using pg8::bf16_t; using pg8::bf16x8; using pg8::f32x4; using pg8::u32x4;
typedef float f32x16 __attribute__((ext_vector_type(16)));
typedef short s16x4 __attribute__((ext_vector_type(4)));
typedef unsigned u32x2 __attribute__((ext_vector_type(2)));
#define LAS __attribute__((address_space(3)))
#define DI __device__ __forceinline__

#ifndef CT_TOK
#define CT_TOK 32768
#endif
constexpr int DM = 1024, FF = 2816, NQKV = 9216, CT = CT_TOK  , NCHUNK = 65536 / CT_TOK + 1, NPH = 18;
constexpr int NTHR = 512;
constexpr int LDS_MISC = 147456;
constexpr int LDS_BYTES = LDS_MISC + 8192;

constexpr size_t SZ_WGU = (size_t)5632 * 1024 * 2, SZ_WDN = (size_t)1024 * 2816 * 2;
constexpr size_t WS_WGU = 0;
constexpr size_t WS_WDN = WS_WGU + 4 * SZ_WGU;
constexpr size_t WS_WQKV = WS_WDN + 4 * SZ_WDN;
constexpr size_t WS_WO = WS_WQKV + (size_t)9216 * 1024 * 2;
constexpr size_t WS_WIN = WS_WO + (size_t)1024 * 1024 * 2;
constexpr size_t WS_WOUT = WS_WIN + (size_t)3072 * 1024 * 2;
constexpr size_t WS_H3 = WS_WOUT + (size_t)1024 * 1024 * 2;
constexpr size_t WS_TW = WS_H3 + (size_t)10240 * 64 * 4;
constexpr size_t WS_BIAS = WS_TW + (size_t)8192 * 8;
constexpr size_t WS_XN = WS_BIAS + (size_t)48 * 132 * 4 + 256 - ((size_t)48 * 132 * 4) % 256;
constexpr size_t WS_H = WS_XN + (size_t)CT * 1024 * 2;
constexpr size_t WS_OG = WS_H;
constexpr size_t WS_LSE = WS_H + (size_t)CT * 3072 * 2;
constexpr size_t WS_BIG = WS_LSE + (size_t)CT * 48 * 4;
constexpr size_t WS_ATT = WS_BIG;
constexpr size_t WS_KF = WS_BIG + (size_t)CT * 9216 * 2;
constexpr size_t KF_BLK = 2 * 16384 + 8192;
constexpr size_t WS_BAR = WS_KF + (size_t)256 * KF_BLK * 8;
constexpr size_t WS_PART = WS_BAR + 16384;
constexpr size_t WS_END = WS_PART + (size_t)CT * 16 * 4;

struct Params { const float* in[26]; float* out; unsigned char* ws; };
enum { I_XP = 0, I_XS, I_RELB, I_F1N, I_F1GU, I_F1D, I_MIXN, I_WQKV, I_WO, I_HWIN, I_HCW, I_HCB, I_HW1, I_HB1, I_HW2, I_HB2, I_HW3, I_HB3, I_HFREQ, I_HW4, I_HSKIP, I_HWOUT,
       I_F2N, I_F2GU, I_F2D, I_FINN };

DI const float* inp(const Params& p, int i) { asm volatile("" : "+s"(i)); return p.in[i]; }
DI int bx_now() { int b = (int)__builtin_amdgcn_workgroup_id_x(); asm volatile("" : "+s"(b)); return b; }
DI unsigned short f2bf(float f) { unsigned u = __float_as_uint(f); u += 0x7fffu + ((u >> 16) & 1u); return (unsigned short)(u >> 16); }
DI float bf2f(unsigned short b) { return __uint_as_float(((unsigned)b) << 16); }
DI float bflo(unsigned w) { return __uint_as_float(w << 16); }
DI float bfhi(unsigned w) { return __uint_as_float(w & 0xffff0000u); }
DI unsigned pk2(float lo, float hi) { return pg8::cvt_pk_bf16(lo, hi); }

DI float row_rs(const float* part, int row) {
    const f32x4* pp = (const f32x4*)(part + (size_t)row * 16); const f32x4 a = pp[0], b = pp[1], c = pp[2], d = pp[3];
    const float ss = ((a[0] + a[1]) + (a[2] + a[3])) + ((b[0] + b[1]) + (b[2] + b[3])) + ((c[0] + c[1]) + (c[2] + c[3])) + ((d[0] + d[1]) + (d[2] + d[3]));
    return rsqrtf(ss * (1.0f / 1024.0f) + 1e-6f);
}
DI void row_rs8(const float* part, int row0, int fq, float (&rs)[8]) {
    f32x4 v[8];
#pragma unroll
    for (int i = 0; i < 8; ++i) v[i] = *(const f32x4*)(part + (size_t)(row0 + (i >> 2) * 128 + (i & 3) * 16) * 16 + fq * 4);
#pragma unroll
    for (int i = 0; i < 8; ++i) { float ss = (v[i][0] + v[i][1]) + (v[i][2] + v[i][3]); ss += __shfl_xor(ss, 16); ss += __shfl_xor(ss, 32); rs[i] = rsqrtf(ss * (1.0f / 1024.0f) + 1e-6f); }
}
struct EpiSwiGLU {
    static constexpr bool PERM = true, AFTER_DRAIN = false;
    bf16_t* O; const float* part;
    DI void operator()(const f32x4 (&acc)[2][2][4][2], const pg8::Unit& u, int wr, int wc, int fr, int fq) const {
        const int row0 = u.pm * 256 + wr * 64 + fr, col0 = u.pn * 128 + wc * 32 + 8 * fq;
        float rs8[8]; row_rs8(part, row0, fq, rs8);
#pragma unroll
        for (int ai = 0; ai < 2; ++ai)
#pragma unroll
            for (int m = 0; m < 4; ++m) {
                const int row = row0 + ai * 128 + m * 16; const float rs = rs8[ai * 4 + m];
                bf16_t* rowp = O + (size_t)row * FF + col0;
                float hv[8];
#pragma unroll
                for (int n = 0; n < 2; ++n)
#pragma unroll
                    for (int j = 0; j < 4; ++j) { const float g = acc[ai][0][m][n][j] * rs, up = acc[ai][1][m][n][j] * rs;
                        hv[n * 4 + j] = g * __builtin_amdgcn_rcpf(1.0f + __expf(-g)) * up; }
                u32x4 w; w.x = pk2(hv[0], hv[1]); w.y = pk2(hv[2], hv[3]); w.z = pk2(hv[4], hv[5]); w.w = pk2(hv[6], hv[7]);
                *(u32x4*)rowp = w;
                asm volatile("" ::: "memory");
            }
    }
};
struct EpiBf {
    static constexpr bool PERM = true, AFTER_DRAIN = false;
    bf16_t* O; int ct; const float* part;
    DI void operator()(const f32x4 (&acc)[2][2][4][2], const pg8::Unit& u, int wr, int wc, int fr, int fq) const {
        const int row0 = u.pm * 256 + wr * 64 + fr, col0 = u.pn * 256 + wc * 32 + 8 * fq;
        float rs8[8]; row_rs8(part, row0, fq, rs8);
#pragma unroll
        for (int ai = 0; ai < 2; ++ai)
#pragma unroll
            for (int m = 0; m < 4; ++m) {
                const int row = row0 + ai * 128 + m * 16; const float rs = rs8[ai * 4 + m];
#pragma unroll
                for (int bj = 0; bj < 2; ++bj) { const f32x4 v0 = acc[ai][bj][m][0] * rs, v1 = acc[ai][bj][m][1] * rs; const int col = col0 + bj * 128;
                    u32x4 w; w.x = pk2(v0[0], v0[1]); w.y = pk2(v0[2], v0[3]); w.z = pk2(v1[0], v1[1]); w.w = pk2(v1[2], v1[3]);
                    *(u32x4*)(O + ((size_t)(col >> 6) * ct + row) * 64 + (col & 63)) = w; }
                asm volatile("" ::: "memory");
            }
    }
};
struct EpiBfT {
    static constexpr bool PERM = false, AFTER_DRAIN = false;
    bf16_t* OT; const float* part; int ct;
    DI void operator()(const f32x4 (&acc)[2][2][4][2], const pg8::Unit& u, int wr, int wc, int fr, int fq) const {
        const int row0 = u.pm * 256 + wr * 64 + fr, col0 = u.pn * 256 + wc * 32 + 4 * fq;
        float rs8[8]; row_rs8(part, row0, fq, rs8);
#pragma unroll
        for (int ai = 0; ai < 2; ++ai)
#pragma unroll
            for (int m = 0; m < 4; ++m) {
                const int row = row0 + ai * 128 + m * 16; const float rs = rs8[ai * 4 + m];
#pragma unroll
                for (int bj = 0; bj < 2; ++bj)
#pragma unroll
                    for (int n = 0; n < 2; ++n) { const f32x4 v = acc[ai][bj][m][n] * rs; const unsigned w01 = pk2(v[0], v[1]), w23 = pk2(v[2], v[3]);
                        bf16_t* cp = OT + (size_t)(col0 + bj * 128 + n * 16) * ct + row;
                        cp[0] = (bf16_t)(w01 & 0xffffu); cp[ct] = (bf16_t)(w01 >> 16); cp[2 * (size_t)ct] = (bf16_t)(w23 & 0xffffu); cp[3 * (size_t)ct] = (bf16_t)(w23 >> 16); }
                asm volatile("" ::: "memory");
            }
    }
};
struct EpiRes {
    static constexpr bool PERM = false, AFTER_DRAIN = false;
    const float* base; float* out; float scale; const float* gnext; bf16_t* xg; float* part;
    DI void operator()(const f32x4 (&acc)[2][2][4][2], const pg8::Unit& u, int wr, int wc, int fr, int fq) const {
        const int row0 = u.pm * 256 + wr * 64 + fr, col0 = u.pn * 256 + wc * 32 + 4 * fq;
        f32x4 gv[2][2];
#pragma unroll
        for (int bj = 0; bj < 2; ++bj)
#pragma unroll
            for (int n = 0; n < 2; ++n) gv[bj][n] = gnext ? *(const f32x4*)(gnext + col0 + bj * 128 + n * 16) : (f32x4){0.f, 0.f, 0.f, 0.f};
        f32x4 bb[3][2][2];
#pragma unroll
        for (int g0 = 0; g0 < 2; ++g0) { const int rown = row0 + (g0 >> 2) * 128 + (g0 & 3) * 16;
#pragma unroll
            for (int bj = 0; bj < 2; ++bj)
#pragma unroll
                for (int n = 0; n < 2; ++n) bb[g0][bj][n] = *(const f32x4*)(base + (size_t)rown * DM + col0 + bj * 128 + n * 16); }
#pragma unroll
        for (int rg = 0; rg < 8; ++rg) { const int ai = rg >> 2, m = rg & 3;
            const int row = row0 + ai * 128 + m * 16; const size_t off = (size_t)row * DM + col0; float ssq = 0.f;
            if (rg < 6) { const int rown = row0 + ((rg + 2) >> 2) * 128 + ((rg + 2) & 3) * 16;
#pragma unroll
                for (int bj = 0; bj < 2; ++bj)
#pragma unroll
                    for (int n = 0; n < 2; ++n) bb[(rg + 2) % 3][bj][n] = *(const f32x4*)(base + (size_t)rown * DM + col0 + bj * 128 + n * 16); }
#pragma unroll
            for (int bj = 0; bj < 2; ++bj)
#pragma unroll
                for (int n = 0; n < 2; ++n) {
                    const f32x4 y = bb[rg % 3][bj][n] + acc[ai][bj][m][n] * scale;
                    *(f32x4*)(out + off + bj * 128 + n * 16) = y;
                    ssq += (y[0] * y[0] + y[1] * y[1]) + (y[2] * y[2] + y[3] * y[3]);
                    if (gnext) { const f32x4 yg = y * gv[bj][n]; u32x2 w; w.x = pk2(yg[0], yg[1]); w.y = pk2(yg[2], yg[3]);
                        *(u32x2*)(xg + off + bj * 128 + n * 16) = w; } }
            ssq += __shfl_xor(ssq, 16); ssq += __shfl_xor(ssq, 32);
            if (fq == 0) part[(size_t)row * 16 + u.pn * 4 + wc] = ssq;
            asm volatile("" ::: "memory");
        }
    }
};

template <int MODE>
DI void convert_wt(const float* __restrict__ W, bf16_t* __restrict__ Bt, int K, int N, float* ldsf, const int tid) {
    const int ntn = N / 64, ntiles = (K / 64) * ntn;
    for (int tile = bx_now(); tile < ntiles; tile += gridDim.x) {
        const int k0 = (tile / ntn) * 64, n0 = (tile % ntn) * 64;
#pragma unroll
        for (int i = 0; i < 8; ++i) { const int idx = tid + NTHR * i, k = idx >> 6, n = idx & 63; ldsf[k * 65 + n] = W[(size_t)(k0 + k) * N + n0 + n]; }
        __syncthreads();
        { const int n = tid >> 3, ks = tid & 7, ncol = n0 + n; int dst = ncol; float sc = 1.0f;
          if (MODE == 1) { if (ncol < FF) dst = 256 * (ncol >> 7) + (ncol & 127); else { const int j = ncol - FF; dst = 256 * (j >> 7) + 128 + (j & 127); } }
          if (MODE == 2) { if ((ncol % 3072) < 1024) sc = 0.125f; }
          float v[8];
#pragma unroll
          for (int j = 0; j < 8; ++j) v[j] = ldsf[(ks * 8 + j) * 65 + n] * sc;
          u32x4 w; w.x = pk2(v[0], v[1]); w.y = pk2(v[2], v[3]); w.z = pk2(v[4], v[5]); w.w = pk2(v[6], v[7]);
          *(u32x4*)(Bt + (size_t)dst * K + k0 + ks * 8) = w; }
        __syncthreads();
    }
}

DI int t5_bucket(int rel) {
    const int n = rel < 0 ? -rel : rel; int ret = rel > 0 ? 16 : 0; int v;
    if (n < 8) v = n;
    else { int k = 0; k += (n >= 15); k += (n >= 27); k += (n >= 50); k += (n >= 91); k += (n >= 166); k += (n >= 305); k += (n >= 559); k += (n >= 1024); v = 8 + k; if (v > 15) v = 15; }
    return ret + v;
}

DI void prologue_small(const Params& p, const int tid) {
    const int lane = tid & 63, wave = tid >> 6;
    unsigned char* ws = p.ws;
    { float2* TW = (float2*)(ws + WS_TW);
      for (int k = bx_now() * NTHR + tid; k < 8192; k += gridDim.x * NTHR) { float s, c; sincospif((float)k * (1.0f / 8192.0f), &s, &c); TW[k] = make_float2(c, -s); } }
    { float* BT = (float*)(ws + WS_BIAS); const float* rb = inp(p, I_RELB);
      for (int i = bx_now() * NTHR + tid; i < 48 * 132; i += gridDim.x * NTHR) { const int gh = i / 132, dd = i % 132, g = gh >> 4; const int d = g == 0 ? 1 : (g == 1 ? 4 : 16);
          float v = 0.f; if (dd <= 128) v = rb[t5_bucket((dd - 64) * d) * 48 + gh]; BT[i] = v; } }
    { float* H3 = (float*)(ws + WS_H3);
      const float* w1 = inp(p, I_HW1); const float* b1 = inp(p, I_HB1); const float* w2 = inp(p, I_HW2); const float* b2 = inp(p, I_HB2);
      const float* w3 = inp(p, I_HW3); const float* b3 = inp(p, I_HB3); const float* fq = inp(p, I_HFREQ);
      const float fr = fq[lane];
      for (int pos = bx_now() * 8 + wave; pos < 10240; pos += gridDim.x * 8) {
          const int L = pos < 2048 ? 2048 : 8192, t = pos < 2048 ? pos : pos - 2048;
          float feat = 0.f;
          if (lane == 0) feat = (float)t / (float)(L - 1);
          else if (lane < 33) { const int b = (lane - 1) & 15; const double frq = 1e-4 + (15.0 - 1e-4) * (double)b / 15.0; double rev = frq * (double)t / (double)L; rev -= floor(rev);
              float s, c; sincospif((float)(2.0 * rev), &s, &c); feat = lane < 17 ? c : -s; }
          float a = b1[lane];
          for (int i = 0; i < 33; ++i) a += __shfl(feat, i) * w1[i * 64 + lane];
          float h = sinf(fr * a);
          a = b2[lane];
          for (int i = 0; i < 64; ++i) a += __shfl(h, i) * w2[i * 64 + lane];
          h = sinf(fr * a);
          a = b3[lane];
          for (int i = 0; i < 64; ++i) a += __shfl(h, i) * w3[i * 64 + lane];
          h = sinf(fr * a);
          if (pos < 2048) H3[(size_t)lane * 2048 + t]= h; else H3[(size_t)2048 * 64 + (size_t)lane * 8192 + t] = h;
      } }
}

DI void norm0_phase(const float* x, const float* g, bf16_t* xg, float* part, int M, const int tid) {
    const int lane = tid & 63, gw = bx_now() * 8 + (tid >> 6), nw = gridDim.x * 8;
    f32x4 gv[4];
#pragma unroll
    for (int i = 0; i < 4; ++i) gv[i] = ((const f32x4*)g)[lane + 64 * i];
    for (int r = gw; r < M; r += nw) {
        const f32x4* xr = (const f32x4*)(x + (size_t)r * DM);
        f32x4 v[4]; float ss = 0.f;
#pragma unroll
        for (int i = 0; i < 4; ++i) { v[i] = xr[lane + 64 * i]; ss += v[i][0] * v[i][0] + v[i][1] * v[i][1] + v[i][2] * v[i][2] + v[i][3] * v[i][3]; }
#pragma unroll
        for (int o = 32; o >= 1; o >>= 1) ss += __shfl_xor(ss, o);
#pragma unroll
        for (int i = 0; i < 4; ++i) { const f32x4 y = v[i] * gv[i]; u32x2 w; w.x = pk2(y[0], y[1]); w.y = pk2(y[2], y[3]); *(u32x2*)(xg + (size_t)r * DM + 4 * (lane + 64 * i)) = w; }
        if (lane < 16) part[(size_t)r * 16 + lane] = lane == 0 ? ss : 0.f;
    }
}
DI void final_phase(float* x, const float* g, const float* part, int M, const int tid) {
    const int lane = tid & 63, gw = bx_now() * 8 + (tid >> 6), nw = gridDim.x * 8;
    f32x4 gv[4];
#pragma unroll
    for (int i = 0; i < 4; ++i) gv[i] = ((const f32x4*)g)[lane + 64 * i];
    for (int r = gw; r < M; r += nw) {
        f32x4* xr = (f32x4*)(x + (size_t)r * DM); const float rs = row_rs(part, r);
#pragma unroll
        for (int i = 0; i < 4; ++i) xr[lane + 64 * i] = xr[lane + 64 * i] * rs * gv[i];
    }
}

DI int crow(int reg, int h) { return (reg & 3) + 8 * (reg >> 2) + 4 * h; }
DI bf16x8 pack8(float a0, float a1, float a2, float a3, float a4, float a5, float a6, float a7) {
    u32x4 p;
    asm volatile("v_cvt_pk_bf16_f32 %0, %4, %5\n\tv_cvt_pk_bf16_f32 %1, %6, %7\n\tv_cvt_pk_bf16_f32 %2, %8, %9\n\tv_cvt_pk_bf16_f32 %3, %10, %11\n\ts_nop 1"
                 : "=&v"(p[0]), "=&v"(p[1]), "=&v"(p[2]), "=&v"(p[3]) : "v"(a0), "v"(a1), "v"(a2), "v"(a3), "v"(a4), "v"(a5), "v"(a6), "v"(a7));
    return __builtin_bit_cast(bf16x8, p);
}
DI s16x4 tr_read(unsigned lds_addr) { s16x4 r; asm volatile("ds_read_b64_tr_b16 %0, %1\n\ts_waitcnt lgkmcnt(0)" : "=&v"(r) : "v"(lds_addr) : "memory"); return r; }
DI void tr_read8(unsigned a, s16x4 (&r)[8]) {
    asm volatile("ds_read_b64_tr_b16 %0, %8\n\tds_read_b64_tr_b16 %1, %8 offset:1152\n\tds_read_b64_tr_b16 %2, %8 offset:64\n\tds_read_b64_tr_b16 %3, %8 offset:1216\n\t"
                 "ds_read_b64_tr_b16 %4, %8 offset:2304\n\tds_read_b64_tr_b16 %5, %8 offset:3456\n\tds_read_b64_tr_b16 %6, %8 offset:2368\n\tds_read_b64_tr_b16 %7, %8 offset:3520\n\ts_waitcnt lgkmcnt(0)"
                 : "=&v"(r[0]), "=&v"(r[1]), "=&v"(r[2]), "=&v"(r[3]), "=&v"(r[4]), "=&v"(r[5]), "=&v"(r[6]), "=&v"(r[7]) : "v"(a) : "memory");
}
#define MFMA32(a, b, c) __builtin_amdgcn_mfma_f32_32x32x16_bf16((a), (b), (c), 0, 0, 0)

constexpr int VIMG_RS = 144, VIMG_BYTES = 32 * VIMG_RS, ATT_BIAS_OFF = 8 * VIMG_BYTES;

DI void attn_phase(const bf16_t* __restrict__ QKV, bf16_t* __restrict__ OG, float* __restrict__ LSE, const float* __restrict__ biasG, unsigned char* lds, int nseq, int S, const int ct, const int tid) {
    const int lane = tid & 63, wave = tid >> 6;
    float* ldsb = (float*)(lds + ATT_BIAS_OFF);
    for (int i = tid; i < 48 * 132; i += NTHR) ldsb[i] = biasG[i];
    __syncthreads();
    unsigned char* img = lds + wave * VIMG_BYTES;
    const unsigned imgaddr = (unsigned)(size_t)img;
    const int r = lane & 31, h = lane >> 5;
    const int i16 = lane & 15, tq_ = i16 >> 2, tp_ = i16 & 3, blk = (lane >> 4) & 1;
    const int tiles_per = S / 32;
    const int nunits = nseq * 3 * 16 * tiles_per;
#ifdef PROBE_ATT
    unsigned long long* pacc3 = (unsigned long long*)(lds + LDS_MISC + 3072); unsigned long long pta = __builtin_amdgcn_s_memrealtime(); const bool pma = (tid == 0);
#define PROBE_A(i) do { const unsigned long long t1_ = __builtin_amdgcn_s_memrealtime(); if (pma) pacc3[i] += t1_ - pta; pta = t1_; } while (0)
#else
#define PROBE_A(i) do { } while (0)
#endif
    const int vb = (gridDim.x == 256) ? ((bx_now() & 7) * 32 + (bx_now() >> 3)) : bx_now();
    for (int u = vb * 8 + wave; u < nunits; u += gridDim.x * 8) {
        PROBE_A(15);
        const int tile_lin = u % tiles_per; int rest = u / tiles_per; const int head = rest & 15; rest >>= 4; const int g = rest % 3, seq = rest / 3;
        const int dsh = 2 * g, d = 1 << dsh, lc = S >> dsh, tpc = lc >> 5;
        const int cls = tile_lin / tpc, tile = tile_lin % tpc;
        const int q0 = tile * 32, qc = q0 + r;
        const size_t seqrow = (size_t)seq * S;
        const size_t tq = seqrow + (size_t)qc * d + cls;
        const bf16_t* Qs = QKV + (size_t)((g * 3 + 0) * 16 + head) * ct * 64; const bf16_t* Ks = QKV + (size_t)((g * 3 + 1) * 16 + head) * ct * 64; const bf16_t* Vs = QKV + (size_t)((g * 3 + 2) * 16 + head) * ct * 64;
        const bf16_t* qp = Qs + tq * 64 + 8 * h;
        bf16x8 bq[4];
#pragma unroll
        for (int s = 0; s < 4; ++s) bq[s] = *(const bf16x8*)(qp + 16 * s);
        f32x16 sacc[5];
        bf16x8 kf[5][4];
#pragma unroll
        for (int kt = 0; kt < 5; ++kt) { const int kc = q0 - 64 + 32 * kt + r; const bool valid = (kc >= 0) && (kc < lc); const int kcc = valid ? kc : qc;
            const bf16_t* kp = Ks + (seqrow + (size_t)kcc * d + cls) * 64 + 8 * h;
#pragma unroll
            for (int s = 0; s < 4; ++s) kf[kt][s] = *(const bf16x8*)(kp + 16 * s); }
#pragma unroll
        for (int kt = 0; kt < 5; ++kt) {
            f32x16 a;
#pragma unroll
            for (int i = 0; i < 16; ++i) a[i] = 0.f;
#pragma unroll
            for (int s = 0; s < 4; ++s) a = MFMA32(kf[kt][s], bq[s], a);
            sacc[kt] = a;
        }
        asm volatile("" ::: "memory");
        PROBE_A(12);
        u32x4 vst[5][4];
#pragma unroll
        for (int kt = 0; kt < 3; ++kt)
#pragma unroll
            for (int i = 0; i < 4; ++i) { const int pid = lane + 64 * i, row = pid >> 3, c16 = pid & 7; const int kc = q0 - 64 + 32 * kt + row; const bool valid = (kc >= 0) && (kc < lc);
                vst[kt][i] = (u32x4){0u, 0u, 0u, 0u};
                if (valid) vst[kt][i] = *(const u32x4*)(Vs + (seqrow + (size_t)kc * d + cls) * 64 + c16 * 8); }
        const float* lb = ldsb + (g * 16 + head) * 132 + 4 * h - r;
        const int kb = q0 - 64 + 4 * h;
        float mx = -1e30f;
#pragma unroll
        for (int kt = 0; kt < 5; ++kt)
#pragma unroll
            for (int i = 0; i < 16; ++i) {
                const int c0 = 32 * kt + (i & 3) + 8 * (i >> 2);
                float sv = sacc[kt][i] + lb[c0];
                bool ok = (unsigned)(kb + c0) < (unsigned)lc;
                if (kt == 0) ok = ok && (crow(i, h) >= r);
                if (kt == 4) ok = ok && (crow(i, h) <= r);
                sv = ok ? sv : -1e30f;
                sacc[kt][i] = sv; mx = fmaxf(mx, sv);
            }
        mx = fmaxf(mx, __shfl_xor(mx, 32));
        float l = 0.f;
#pragma unroll
        for (int kt = 0; kt < 5; ++kt)
#pragma unroll
            for (int i = 0; i < 16; ++i) { const float pv = __expf(sacc[kt][i] - mx); sacc[kt][i] = pv; l += pv; }
        l += __shfl_xor(l, 32);
        bf16x8 pfr[5][2];
#pragma unroll
        for (int kt = 0; kt < 5; ++kt)
#pragma unroll
            for (int s = 0; s < 2; ++s)
                pfr[kt][s] = pack8(sacc[kt][8 * s], sacc[kt][8 * s + 1], sacc[kt][8 * s + 2], sacc[kt][8 * s + 3], sacc[kt][8 * s + 4], sacc[kt][8 * s + 5], sacc[kt][8 * s + 6], sacc[kt][8 * s + 7]);
        asm volatile("" ::: "memory");
        PROBE_A(13);
        f32x16 oacc[2];
#pragma unroll
        for (int i = 0; i < 16; ++i) { oacc[0][i] = 0.f; oacc[1][i] = 0.f; }
#pragma unroll
        for (int kt = 3; kt < 5; ++kt)
#pragma unroll
            for (int i = 0; i < 4; ++i) { const int pid = lane + 64 * i, row = pid >> 3, c16 = pid & 7; const int kc = q0 - 64 + 32 * kt + row; const bool valid = (kc >= 0) && (kc < lc);
                vst[kt][i] = (u32x4){0u, 0u, 0u, 0u};
                if (valid) vst[kt][i] = *(const u32x4*)(Vs + (seqrow + (size_t)kc * d + cls) * 64 + c16 * 8); }
#pragma unroll
        for (int kt = 0; kt < 5; ++kt) {
#pragma unroll
            for (int i = 0; i < 4; ++i) { const int pid = lane + 64 * i, row = pid >> 3, c16 = pid & 7; *(u32x4*)(img + row * VIMG_RS + c16 * 16) = vst[kt][i]; }
            asm volatile("s_waitcnt lgkmcnt(0)" ::: "memory");
            s16x4 tr[8]; tr_read8(imgaddr + (4 * h + tq_) * VIMG_RS + 32 * blk + 8 * tp_, tr);
#pragma unroll
            for (int s = 0; s < 2; ++s) {
                const bf16x8 pf = pfr[kt][s];
#pragma unroll
                for (int et = 0; et < 2; ++et) {
                    const bf16x8 vf = __builtin_shufflevector(tr[4 * s + 2 * et], tr[4 * s + 2 * et + 1], 0, 1, 2, 3, 4, 5, 6, 7);
                    oacc[et] = MFMA32(vf, pf, oacc[et]);
                }
            }
        }
        PROBE_A(14);
        const float inv = 1.0f / l, lse = mx + __logf(l);
        bf16_t* op = OG + tq * 3072 + g * 1024 + head * 64;
#pragma unroll
        for (int et = 0; et < 2; ++et)
#pragma unroll
            for (int gq = 0; gq < 4; ++gq) { u32x2 w; w.x = pk2(oacc[et][4 * gq] * inv, oacc[et][4 * gq + 1] * inv); w.y = pk2(oacc[et][4 * gq + 2] * inv, oacc[et][4 * gq + 3] * inv);
                *(u32x2*)(op + et * 32 + 8 * gq + 4 * h) = w; }
        if (h == 0) LSE[tq * 48 + g * 16 + head] = lse;
    }
    __syncthreads();
}

DI void merge_phase(const bf16_t* __restrict__ OG, const float* __restrict__ LSE, bf16_t* __restrict__ ATT, const int ct, const int tid) {
    const int total = ct * 128;
#pragma unroll 4
    for (int idx = bx_now() * NTHR + tid; idx < total; idx += gridDim.x * NTHR) {
        const int tok = idx >> 7, c8 = idx & 127, head = c8 >> 3;
        const float l0 = LSE[tok * 48 + head], l1 = LSE[tok * 48 + 16 + head], l2 = LSE[tok * 48 + 32 + head];
        const float m = fmaxf(l0, fmaxf(l1, l2));
        float a0 = __expf(l0 - m), a1 = __expf(l1 - m), a2 = __expf(l2 - m); const float inv = 1.0f / (a0 + a1 + a2); a0 *= inv; a1 *= inv; a2 *= inv;
        const u32x4 o0 = *(const u32x4*)(OG + (size_t)tok * 3072 + c8 * 8), o1 = *(const u32x4*)(OG + (size_t)tok * 3072 + 1024 + c8 * 8), o2 = *(const u32x4*)(OG + (size_t)tok * 3072 + 2048 + c8 * 8);
        u32x4 w;
#pragma unroll
        for (int j = 0; j < 4; ++j) { const float lo = a0 * bflo(o0[j]) + a1 * bflo(o1[j]) + a2 * bflo(o2[j]); const float hi = a0 * bfhi(o0[j]) + a1 * bfhi(o1[j]) + a2 * bfhi(o2[j]); w[j] = pk2(lo, hi); }
        *(u32x4*)(ATT + (size_t)tok * 1024 + c8 * 8) = w;
    }
}

DI void ztrans_phase(const bf16_t* __restrict__ ZT, bf16_t* __restrict__ ZR, unsigned char* lds, int nseq, int L, const int tid) {
    const int tt = L / 64, ntiles = nseq * tt * 16;
    for (int tile0 = bx_now() * 4; tile0 < ntiles; tile0 += gridDim.x * 4) {
        u32x4 ld[4];
#pragma unroll
        for (int k = 0; k < 4; ++k) { const int tile = tile0 + k; const int ct = tile % 16; int rest = tile / 16; const int ti = rest % tt, seq = rest / tt; const int ch0 = ct * 64, t0 = ti * 64;
            const int row = tid >> 3, c16 = tid & 7; ld[k] = (u32x4){0u, 0u, 0u, 0u};
            if (tile < ntiles) ld[k] = *(const u32x4*)(ZT + ((size_t)seq * 1024 + ch0 + row) * L + t0 + c16 * 8); }
#pragma unroll
        for (int k = 0; k < 4; ++k) { const int row = tid >> 3, c16 = tid & 7; *(u32x4*)(lds + k * 9216 + row * 144 + c16 * 16) = ld[k]; }
        __syncthreads();
#pragma unroll
        for (int k = 0; k < 4; ++k) { const int tile = tile0 + k; const int ct = tile % 16; int rest = tile / 16; const int ti = rest % tt, seq = rest / tt; const int ch0 = ct * 64, t0 = ti * 64;
            const int t = tid & 63, cgp = tid >> 6; unsigned short v[8];
#pragma unroll
            for (int j = 0; j < 8; ++j) v[j] = *(const bf16_t*)(lds + k * 9216 + (cgp * 8 + j) * 144 + t * 2);
            u32x4 w; w.x = v[0] | ((unsigned)v[1] << 16); w.y = v[2] | ((unsigned)v[3] << 16); w.z = v[4] | ((unsigned)v[5] << 16); w.w = v[6] | ((unsigned)v[7] << 16);
            if (tile < ntiles) *(u32x4*)(ZR + ((size_t)seq * L + t0 + t) * 1024 + ch0 + cgp * 8) = w; }
        __syncthreads();
    }
}

DI int pidx(int i) { return i + (i >> 3); }
DI float2 cmul(float2 a, float2 b) { return make_float2(a.x * b.x - a.y * b.y, a.x * b.y + a.y * b.x); }
DI float2 tw_hw(int ju, int lmu) { const float rev = (float)ju * __uint_as_float((unsigned)(127 - (lmu + 1)) << 23); return make_float2(__builtin_amdgcn_cosf(rev), -__builtin_amdgcn_sinf(rev)); }
DI float2 ld_agent_f2(const float2* p) { const unsigned long long w = __hip_atomic_load((const unsigned long long*)p, __ATOMIC_RELAXED, __HIP_MEMORY_SCOPE_AGENT);
    return make_float2(__uint_as_float((unsigned)w), __uint_as_float((unsigned)(w >> 32))); }
template <int R, bool INV, int LOG2N, int NB, bool MUL = false>
DI void fft_pass(float2* buf, int s, const int tid, const float2* kfp = nullptr) {
    constexpr int N = 1 << LOG2N, NP = 1 << R, NPAD = N + N / 8;
    const int lmp = LOG2N - s - R, mp = 1 << lmp;
#pragma unroll 1
    for (int w = tid; w < (N >> R); w += NTHR) {
        const int jp = w & (mp - 1), blk = w >> lmp, base = (blk << (lmp + R)) + jp;
        float2 tw[R][NP / 2];
        { float2 bu = tw_hw(jp, lmp + R - 1); const float c8 = 0.70710678118654752f;
#pragma unroll
          for (int u = 0; u < R; ++u) { const int hq = 1 << (R - 1 - u);
              tw[u][0] = bu;
              if (hq >= 2) tw[u][hq / 2] = make_float2(bu.y, -bu.x);
              if (hq == 4) { tw[u][1] = make_float2(c8 * (bu.x + bu.y), c8 * (bu.y - bu.x)); tw[u][3] = make_float2(c8 * (bu.y - bu.x), -c8 * (bu.x + bu.y)); }
              bu = cmul(bu, bu); }
          if (INV) {
#pragma unroll
              for (int u = 0; u < R; ++u)
#pragma unroll
                  for (int k = 0; k < NP / 2; ++k) if (k < (1 << (R - 1 - u))) tw[u][k].y = -tw[u][k].y; } }
        float2 kfv[NP];
        if (MUL) {
#pragma unroll
            for (int q = 0; q < NP; ++q) kfv[q] = ld_agent_f2(kfp + base + q * mp); }
#pragma unroll
        for (int nb = 0; nb < NB; ++nb) {
            float2* bp = buf + nb * NPAD;
            float2 v[NP];
#pragma unroll
            for (int q = 0; q < NP; ++q) v[q] = bp[pidx(base + q * mp)];
            if (!INV) {
#pragma unroll
                for (int u = 0; u < R; ++u) { const int hq = 1 << (R - 1 - u);
#pragma unroll
                    for (int q = 0; q < NP; ++q) if (!(q & hq)) { const float2 a = v[q], b = v[q + hq]; v[q] = make_float2(a.x + b.x, a.y + b.y); v[q + hq] = cmul(make_float2(a.x - b.x, a.y - b.y), tw[u][q & (hq - 1)]); } }
            } else {
#pragma unroll
                for (int u = R - 1; u >= 0; --u) { const int hq = 1 << (R - 1 - u);
#pragma unroll
                    for (int q = 0; q < NP; ++q) if (!(q & hq)) { const float2 a = v[q], b = cmul(v[q + hq], tw[u][q & (hq - 1)]); v[q] = make_float2(a.x + b.x, a.y + b.y); v[q + hq] = make_float2(a.x - b.x, a.y - b.y); } }
            }
#pragma unroll
            for (int q = 0; q < NP; ++q) bp[pidx(base + q * mp)] = MUL ? cmul(v[q], kfv[q]) : v[q];
        }
    }
    __syncthreads();
}
template <int LOG2N, int NB> DI void fft_fwd(float2* buf, const int tid) {
    fft_pass<3, false, LOG2N, NB>(buf, 0, tid); fft_pass<3, false, LOG2N, NB>(buf, 3, tid); fft_pass<3, false, LOG2N, NB>(buf, 6, tid); fft_pass<3, false, LOG2N, NB>(buf, 9, tid);
    if (LOG2N == 14) fft_pass<2, false, LOG2N, NB>(buf, 12, tid);
}
template <int LOG2N, int NB> DI void fft_fwd_mul(float2* buf, const float2* kfp, const int tid) {
    fft_pass<3, false, LOG2N, NB>(buf, 0, tid); fft_pass<3, false, LOG2N, NB>(buf, 3, tid); fft_pass<3, false, LOG2N, NB>(buf, 6, tid);
    if (LOG2N == 14) { fft_pass<3, false, LOG2N, NB>(buf, 9, tid); fft_pass<2, false, LOG2N, NB, true>(buf, 12, tid, kfp); }
    else fft_pass<3, false, LOG2N, NB, true>(buf, 9, tid, kfp);
}
template <int LOG2N, int NB> DI void fft_inv(float2* buf, const int tid) {
    if (LOG2N == 14) fft_pass<2, true, LOG2N, NB>(buf, 12, tid);
    fft_pass<3, true, LOG2N, NB>(buf, 9, tid); fft_pass<3, true, LOG2N, NB>(buf, 6, tid); fft_pass<3, true, LOG2N, NB>(buf, 3, tid); fft_pass<3, true, LOG2N, NB>(buf, 0, tid);
}
DI void conv4(const bf16_t* rowp, int t0, int L, float w0, float w1, float w2, float b, float (&o)[4]) {
    const u32x2 q = *(const u32x2*)(rowp + t0);
    const float um = t0 > 0 ? bf2f(rowp[t0 - 1]) : 0.f, up = t0 + 4 < L ? bf2f(rowp[t0 + 4]) : 0.f;
    const float u0 = bflo(q.x), u1 = bfhi(q.x), u2 = bflo(q.y), u3 = bfhi(q.y);
    o[0] = um * w0 + u0 * w1 + u1 * w2 + b; o[1] = u0 * w0 + u1 * w1 + u2 * w2 + b; o[2] = u1 * w0 + u2 * w1 + u3 * w2 + b; o[3] = u2 * w0 + u3 * w1 + up * w2 + b;
}

template <int LOG2N, int NB>
DI void hyena_fft_phase(const bf16_t* __restrict__ UT, bf16_t* __restrict__ ZT, const float* __restrict__ H3, const float* __restrict__ w4, const float* __restrict__ skip,
                        float2* KFblk, unsigned char* lds, const int tid, const bool make_filter, const float* __restrict__ cw, const float* __restrict__ cb, const int ct, const int ngroups, float2* TMP) {
    constexpr int N = 1 << LOG2N, L = N / 2, PT = L / NTHR, NBF = NB >= 2 ? 2 : 1, NPAD = N + N / 8;
    float2* buf = (float2*)lds; float* w4s = (float*)(lds + LDS_MISC); float2* Z1 = KFblk + 2 * 16384;
    const float invN = 1.0f / (float)N;
#if defined(PROBE_SEL) && !defined(PROBE_GEMM) && !defined(PROBE_ATT)
    unsigned long long* pacc2 = (unsigned long long*)(lds + LDS_MISC + 3072); unsigned long long ptp = __builtin_amdgcn_s_memrealtime(); const bool pme = (tid == 0);
#define PROBE_T(i) do { const unsigned long long t1_ = __builtin_amdgcn_s_memrealtime(); if (pme) pacc2[i] += t1_ - ptp; ptp = t1_; } while (0)
#else
#define PROBE_T(i) do { } while (0)
#endif
    if (NBF == 1) {
        float* w16 = (float*)(lds + LDS_MISC + 4096);
        for (int i = tid; i < 1024; i += NTHR) { const int j = i >> 4, ci = (i >> 2) & 3, q = i & 3; w16[i] = w4[(size_t)j * 4096 + q * 1024 + bx_now() + 256 * ci]; }
        __syncthreads();
        float adl[4];
#pragma unroll
        for (int ci = 0; ci < 4; ++ci) adl[ci] = fabsf(-3.0701134573253945f + (-15.350567286626972f + 3.0701134573253945f) * ((float)(bx_now() + 256 * ci) / 1023.0f));
#pragma unroll 1
        for (int i0 = 0; i0 < PT; i0 += 4) {
            const float* hp = H3 + tid + NTHR * i0;
            float acc[4][4][4];
#pragma unroll
            for (int ci = 0; ci < 4; ++ci)
#pragma unroll
                for (int q = 0; q < 4; ++q)
#pragma unroll
                    for (int k = 0; k < 4; ++k) acc[ci][q][k] = 0.f;
            int zo = 0; asm volatile("" : "+v"(zo));
            const f32x4* wq = (const f32x4*)(w16 + zo);
#pragma unroll 4
            for (int j = 0; j < 64; ++j) { float hv[4];
#pragma unroll
                for (int k = 0; k < 4; ++k) hv[k] = hp[(size_t)j * L + NTHR * k];
#pragma unroll
                for (int ci = 0; ci < 4; ++ci) { const f32x4 wv = wq[j * 4 + ci];
#pragma unroll
                    for (int k = 0; k < 4; ++k) { acc[ci][0][k] += hv[k] * wv[0]; acc[ci][1][k] += hv[k] * wv[1]; acc[ci][2][k] += hv[k] * wv[2]; acc[ci][3][k] += hv[k] * wv[3]; } } }
#pragma unroll
            for (int k = 0; k < 4; ++k) { const int t = tid + NTHR * (i0 + k); const float tl = (float)t / (float)(L - 1);
#pragma unroll
                for (int ci = 0; ci < 4; ++ci) { const float dec = __expf(-tl * adl[ci]);
                    TMP[(size_t)(2 * ci + 0) * L + t] = make_float2(acc[ci][0][k] * dec, acc[ci][1][k] * dec);
                    TMP[(size_t)(2 * ci + 1) * L + t] = make_float2(acc[ci][2][k] * dec, acc[ci][3][k] * dec); } } }
        __syncthreads();
    }
    int chi = 0;
    for (int ch = bx_now(); ch < DM; ch += gridDim.x, ++chi) {
        int tidc = tid; asm volatile("" : "+v"(tidc));
        float zf = 0.f; asm volatile("" : "+v"(zf));
        float2* KF = KFblk + (LOG2N == 12 ? (size_t)chi * 2 * N : 0);
        PROBE_T(15);
        const float sk0 = skip[ch], sk1 = skip[1024 + ch];
        const float zw0 = cw[2048 + ch], zw1 = cw[3072 + 2048 + ch], zw2 = cw[6144 + 2048 + ch], zb = cb[2048 + ch];
        if (make_filter) {
        if (tidc < 256) { const int j = tidc >> 2, q = tidc & 3; w4s[tidc] = w4[(size_t)j * 4096 + q * 1024 + ch]; }
        __syncthreads();
        const float mind = -3.0701134573253945f, maxd = -15.350567286626972f;
        const float adelta = fabsf(mind + (maxd - mind) * ((float)ch / 1023.0f));
#pragma unroll 1
        for (int i0 = 0; i0 < (NBF == 2 ? PT : 0); i0 += 4) {
            const float* hp = H3 + tidc + NTHR * i0;
            float f[2][4], b[2][4];
#pragma unroll
            for (int oo = 0; oo < 2; ++oo)
#pragma unroll
                for (int k = 0; k < 4; ++k) { f[oo][k] = 0.f; b[oo][k] = 0.f; }
            int zo = 0; asm volatile("" : "+v"(zo));
            const f32x4* wq = (const f32x4*)(w4s + zo);
#pragma unroll 8
            for (int j = 0; j < 64; ++j) { float hv[4];
#pragma unroll
                for (int k = 0; k < 4; ++k) hv[k] = hp[(size_t)j * L + NTHR * k];
                const f32x4 wv = wq[j];
#pragma unroll
                for (int k = 0; k < 4; ++k) { f[0][k] += hv[k] * wv[0]; b[0][k] += hv[k] * wv[1]; f[1][k] += hv[k] * wv[2]; b[1][k] += hv[k] * wv[3]; } }
#pragma unroll
            for (int k = 0; k < 4; ++k) { const int t = tidc + NTHR * (i0 + k); const float dec = __expf(-((float)t / (float)(L - 1)) * adelta);
#pragma unroll
                for (int oo = 0; oo < 2; ++oo) { const float fv = f[oo][k] * dec, bv = b[oo][k] * dec;
                    if (oo < NBF) { float2* bo = buf + oo * NPAD; bo[pidx(t)] = make_float2(fv, 0.f); if (t == 0) bo[pidx(L)] = make_float2(zf, zf); else bo[pidx(N - t)] = make_float2(bv, 0.f); }
                    else Z1[t] = make_float2(fv, bv); } } }
        if (NBF == 1) {
#pragma unroll 2
            for (int i = 0; i < PT; ++i) { const int t = tidc + NTHR * i; const float2 v0 = TMP[(size_t)(2 * chi + 0) * L + t], v1 = TMP[(size_t)(2 * chi + 1) * L + t];
                buf[pidx(t)] = make_float2(v0.x, v1.x); if (t == 0) buf[pidx(L)] = make_float2(zf, zf); else buf[pidx(N - t)] = make_float2(v0.y, v1.y); }
            __syncthreads();
            fft_fwd<LOG2N, 1>(buf, tidc);
#pragma unroll 1
            for (int i = 0; i < 2 * PT; ++i) { const int idx = tidc + NTHR * i;
                const unsigned f = __brev((unsigned)idx) >> (32 - LOG2N), f2 = (N - f) & (N - 1), p2 = __brev(f2) >> (32 - LOG2N);
                const float2 c = buf[pidx(idx)], d = buf[pidx((int)p2)];
                KF[idx] = make_float2(0.5f * (c.x + d.x), 0.5f * (c.y - d.y));
                KF[(size_t)N + idx] = make_float2(0.5f * (c.y + d.y), 0.5f * (d.x - c.x)); }
            __syncthreads();
        } else {
#pragma unroll 1
        for (int og = 0; og < 2; og += NBF) {
            __syncthreads();
            fft_fwd<LOG2N, NBF>(buf, tidc);
#pragma unroll 1
            for (int i = 0; i < 2 * PT; ++i) { const int idx = tidc + NTHR * i;
#pragma unroll
                for (int oo = 0; oo < NBF; ++oo) KF[(size_t)(og + oo) * N + idx] = buf[oo * NPAD + pidx(idx)]; }
            __syncthreads();
        }
        }
        asm volatile("s_waitcnt vmcnt(0)" ::: "memory");
        }
        __syncthreads();
        PROBE_T(12);
#pragma unroll 1
        for (int gp = 0; gp < ngroups; ++gp) {
        int tidg = tidc; asm volatile("" : "+v"(tidg));
#pragma unroll
        for (int pr = 0; pr < NB; ++pr) { const size_t sa = (size_t)(2 * (gp * NB + pr)), sb = sa + 1;
            const bf16_t* zpa = UT + (size_t)(2048 + ch) * ct + sa * L; const bf16_t* zpb = UT + (size_t)(2048 + ch) * ct + sb * L; float2* bp = buf + pr * NPAD;
#pragma unroll 2
            for (int i = 0; i < PT / 4; ++i) { const int t0 = 4 * (tidg + NTHR * i); float za[4], zb4[4]; conv4(zpa, t0, L, zw0, zw1, zw2, zb, za); conv4(zpb, t0, L, zw0, zw1, zw2, zb, zb4);
#pragma unroll
                for (int j = 0; j < 4; ++j) { bp[pidx(t0 + j)] = make_float2(za[j], zb4[j]); bp[pidx(t0 + j + L)] = make_float2(zf, zf); } } }
        PROBE_T(13);
#pragma unroll 1
        for (int o = 0; o < 2; ++o) {
            asm volatile("" : "+v"(tidg));
            __syncthreads();
            fft_fwd_mul<LOG2N, NB>(buf, KF + (size_t)o * N, tidg);
            fft_inv<LOG2N, NB>(buf, tidg);
            PROBE_T(14);
            const float sk = o == 0 ? sk0 : sk1;
            const float xw0 = cw[o * 1024 + ch], xw1 = cw[3072 + o * 1024 + ch], xw2 = cw[6144 + o * 1024 + ch], xb = cb[o * 1024 + ch];
#pragma unroll
            for (int pr = 0; pr < NB; ++pr) { const size_t sa = (size_t)(2 * (gp * NB + pr)), sb = sa + 1;
                const bf16_t* zpa = UT + (size_t)(2048 + ch) * ct + sa * L; const bf16_t* zpb = UT + (size_t)(2048 + ch) * ct + sb * L;
                const bf16_t* xpa = UT + (size_t)(o * 1024 + ch) * ct + sa * L; const bf16_t* xpb = UT + (size_t)(o * 1024 + ch) * ct + sb * L;
                bf16_t* opa = ZT + (sa * 1024 + ch) * L; bf16_t* opb = ZT + (sb * 1024 + ch) * L; float2* bp = buf + pr * NPAD; float2* z1p = Z1 + pr * L;
#pragma unroll 2
                for (int i = 0; i < PT / 4; ++i) { const int t0 = 4 * (tidg + NTHR * i);
                    float xa[4], xb4[4]; conv4(xpa, t0, L, xw0, xw1, xw2, xb, xa); conv4(xpb, t0, L, xw0, xw1, xw2, xb, xb4);
                    float za[4], zb4[4];
                    if (o == 0) { conv4(zpa, t0, L, zw0, zw1, zw2, zb, za); conv4(zpb, t0, L, zw0, zw1, zw2, zb, zb4); }
                    else { const f32x4 q0 = *(const f32x4*)(z1p + t0), q1 = *(const f32x4*)(z1p + t0 + 2); za[0] = q0[0]; zb4[0] = q0[1]; za[1] = q0[2]; zb4[1] = q0[3]; za[2] = q1[0]; zb4[2] = q1[1]; za[3] = q1[2]; zb4[3] = q1[3]; }
                    float na[4], nb[4];
#pragma unroll
                    for (int j = 0; j < 4; ++j) { const float2 c = bp[pidx(t0 + j)]; na[j] = xa[j] * (c.x * invN + za[j] * sk); nb[j] = xb4[j] * (c.y * invN + zb4[j] * sk); }
                    if (o == 0) { *(f32x4*)(z1p + t0) = (f32x4){na[0], nb[0], na[1], nb[1]}; *(f32x4*)(z1p + t0 + 2) = (f32x4){na[2], nb[2], na[3], nb[3]};
#pragma unroll
                        for (int j = 0; j < 4; ++j) { bp[pidx(t0 + j)] = make_float2(na[j], nb[j]); bp[pidx(t0 + j + L)] = make_float2(zf, zf); } }
                    else { u32x2 wa, wb; wa.x = pk2(na[0], na[1]); wa.y = pk2(na[2], na[3]); wb.x = pk2(nb[0], nb[1]); wb.y = pk2(nb[2], nb[3]); *(u32x2*)(opa + t0) = wa; *(u32x2*)(opb + t0) = wb; } } }
            PROBE_T(15);
        }
        __syncthreads();
        }
    }
}

#define XB_TMO      128
#define XB_XCNT(j)  (256  + 64 * (j))
#define XB_XSUB(j)  (1280 + 64 * (j))
#define XB_XGEN(j)  (2304 + 64 * (j))
#define XB_TOP      3328
#define XB_TOPGEN   3392
#define XCD_BAR_WORDS 3456
#define XB_SPIN_CAP (1u << 18)

__device__ __forceinline__ unsigned xb_ld(unsigned* p)              { return __hip_atomic_load(p, __ATOMIC_RELAXED, __HIP_MEMORY_SCOPE_AGENT); }
__device__ __forceinline__ unsigned xb_add(unsigned* p, unsigned v) { return __hip_atomic_fetch_add(p, v, __ATOMIC_RELAXED, __HIP_MEMORY_SCOPE_AGENT); }
__device__ __forceinline__ unsigned xb_xcc_id() { return (unsigned)__builtin_amdgcn_s_getreg((3 << 11) | 20) & 0xFu; }
#define XB_SPIN(cond, bar) do { unsigned _sp = 0; while (cond) { __builtin_amdgcn_s_sleep(1); \
    if ((++_sp & 255u) == 0u) { if (xb_ld(&(bar)[XB_TMO])) break; if (_sp > XB_SPIN_CAP) { atomicAdd(&(bar)[XB_TMO], 1u); break; } } } } while (0)

struct XcdBarrier {
    unsigned* bar; unsigned x;
    volatile LAS unsigned* st;
};

__device__ __forceinline__ XcdBarrier xcd_barrier_post(unsigned* bar, volatile LAS unsigned* st, const int tid) {
    XcdBarrier b; b.bar = bar; b.x = xb_xcc_id(); b.st = st;
    if (tid == 0) { const unsigned rank = xb_add(&bar[XB_XCNT(b.x)], 1u); st[2] = rank * 8u + b.x; }
    return b;
}
__device__ __forceinline__ void xcd_barrier_complete(unsigned* bar, unsigned x, unsigned& nloc, unsigned& nx) {
    const unsigned G = gridDim.x * gridDim.y * gridDim.z;
    unsigned sum, cnt, mine, sp = 0u;
    for (;;) {
        sum = 0u; cnt = 0u; mine = 0u;
#pragma unroll
        for (unsigned j = 0; j < 16; ++j) { const unsigned c = xb_ld(&bar[XB_XCNT(j)]); sum += c; cnt += (c > 0u) ? 1u : 0u; mine = (j == x) ? c : mine; }
        if (sum == G) break;
        __builtin_amdgcn_s_sleep(1);
        if ((++sp & 255u) == 0u) { if (xb_ld(&bar[XB_TMO])) break; if (sp > XB_SPIN_CAP) { atomicAdd(&bar[XB_TMO], 1u); break; } }
    }
    nloc = mine > 0u ? mine : 1u; nx = cnt > 0u ? cnt : 1u;
}

__device__ __forceinline__ void xcd_barrier(const XcdBarrier& b, const int tid) {
    asm volatile("s_waitcnt vmcnt(0)" ::: "memory");
    __syncthreads();
    if (tid == 0) {
        unsigned* bar = b.bar;
        __builtin_amdgcn_s_waitcnt(0);
        unsigned nloc = b.st[0], nx = b.st[1];
        if (nloc == 0u) { xcd_barrier_complete(bar, b.x, nloc, nx); b.st[0] = nloc; b.st[1] = nx; }
        const unsigned old = xb_add(&bar[XB_XSUB(b.x)], 1u);
        const unsigned gen = old / nloc;
        if (old + 1u == (gen + 1u) * nloc) {
            __builtin_amdgcn_fence(__ATOMIC_RELEASE, "agent");
            asm volatile("s_waitcnt vmcnt(0)" ::: "memory");
            const unsigned og = xb_add(&bar[XB_TOP], 1u);
            const unsigned tg = og / nx;
            if (og + 1u == (tg + 1u) * nx) xb_add(&bar[XB_TOPGEN], 1u);
            else XB_SPIN(xb_ld(&bar[XB_TOPGEN]) == tg, bar);
            __builtin_amdgcn_fence(__ATOMIC_ACQUIRE, "agent");
            xb_add(&bar[XB_XGEN(b.x)], 1u);
            asm volatile("s_waitcnt vmcnt(0)" ::: "memory");
        } else {
            XB_SPIN(xb_ld(&bar[XB_XGEN(b.x)]) == gen, bar);
            __builtin_amdgcn_fence(__ATOMIC_ACQUIRE, "agent");
            asm volatile("s_waitcnt vmcnt(0)" ::: "memory");
        }
    }
    __syncthreads();
}


DI int tid_now(int wave_s) { unsigned m = ~0u; asm volatile("" : "+s"(m)); return wave_s * 64 + (int)__builtin_amdgcn_mbcnt_hi(m, __builtin_amdgcn_mbcnt_lo(m, 0u)); }
__global__ void __launch_bounds__(NTHR) fwd_megakernel(Params p) {
    extern __shared__ __attribute__((aligned(16))) unsigned char lds[];
    cg::grid_group grid = cg::this_grid();
    unsigned char* ws = p.ws;
    LAS unsigned char* ldsl = (LAS unsigned char*)lds;
    const int G = gridDim.x, bx = bx_now();
    const int wave_s = __builtin_amdgcn_readfirstlane(threadIdx.x >> 6);
#define TID_NOW() tid_now(wave_s)
    int tid = TID_NOW(); asm volatile("" : "+v"(tid));

    for (int li = 0; li < 2; ++li) {
        convert_wt<1>(inp(p, I_F1GU) + (size_t)li * 1024 * 5632, (bf16_t*)(ws + WS_WGU + (size_t)li * SZ_WGU), 1024, 5632, (float*)lds, tid);
        convert_wt<1>(inp(p, I_F2GU) + (size_t)li * 1024 * 5632, (bf16_t*)(ws + WS_WGU + (size_t)(2 + li) * SZ_WGU), 1024, 5632, (float*)lds, tid);
        convert_wt<0>(inp(p, I_F1D) + (size_t)li * 2816 * 1024, (bf16_t*)(ws + WS_WDN + (size_t)li * SZ_WDN), 2816, 1024, (float*)lds, tid);
        convert_wt<0>(inp(p, I_F2D) + (size_t)li * 2816 * 1024, (bf16_t*)(ws + WS_WDN + (size_t)(2 + li) * SZ_WDN), 2816, 1024, (float*)lds, tid);
    }
    convert_wt<2>(inp(p, I_WQKV), (bf16_t*)(ws + WS_WQKV), 1024, 9216, (float*)lds, tid);
    for (int li = 0; li < 3; ++li) {
        const float* W = li == 0 ? inp(p, I_WO) : (li == 1 ? inp(p, I_HWIN) : inp(p, I_HWOUT));
        bf16_t* Bt = (bf16_t*)(ws + (li == 0 ? WS_WO : (li == 1 ? WS_WIN : WS_WOUT)));
        convert_wt<0>(W, Bt, 1024, li == 1 ? 3072 : 1024, (float*)lds, tid);
    }
    prologue_small(p, tid);
    if (bx == 0) for (int i = tid; i < XCD_BAR_WORDS; i += NTHR) ((unsigned*)(ws + WS_BAR))[i] = 0u;
    if (tid == 0) { ((unsigned*)(lds + LDS_MISC + 2048))[0] = 0u; ((unsigned*)(lds + LDS_MISC + 2048))[1] = 0u; ((unsigned*)(lds + LDS_MISC + 2048))[2] = 0u; ((unsigned*)(lds + LDS_MISC + 2048))[3] = 0u; }
#ifdef PROBE_SEL
    unsigned long long* pacc = (unsigned long long*)(lds + LDS_MISC + 3072);
    unsigned long long pt_prev = 0, pt_start = 0;
    if (tid == 0) { for (int i = 0; i < 16; ++i) pacc[i] = 0ull; }
    pt_start = __builtin_amdgcn_s_memrealtime();
#endif
    __syncthreads();
    grid.sync();
#ifdef PROBE_SEL
    pt_prev = __builtin_amdgcn_s_memrealtime();
    if (TID_NOW() == 0) pacc[11] = pt_prev - pt_start;
#endif
    XcdBarrier xbar = xcd_barrier_post((unsigned*)(ws + WS_BAR), (volatile LAS unsigned*)(lds + LDS_MISC + 2048), tid);
    int vbx = bx;


    for (int c = 0; c < NCHUNK; ++c) {
#pragma unroll 1
        for (int ph = 0; ph < NPH; ++ph) {
            tid = TID_NOW(); asm volatile("" : "+v"(tid));
            int kind = 0, widx = 0;
            switch (ph) {
                case 0: kind = 0; break;  case 1: kind = 1; widx = 0; break;  case 2: kind = 2; widx = 0; break;
                case 3: kind = 3; break;  case 4: kind = 4; break;  case 5: kind = 5; break;  case 6: kind = 2; widx = 4; break;
                case 7: kind = 1; widx = 2; break;  case 8: kind = 2; widx = 2; break;
                case 9: kind = 1; widx = 1; break;  case 10: kind = 2; widx = 1; break;
                case 11: kind = 6; break; case 12: kind = 7; break; case 13: kind = 8; break; case 14: kind = 2; widx = 5; break;
                case 15: kind = 1; widx = 3; break; case 16: kind = 2; widx = 3; break;
                default: kind = 9; break;
            }
#ifndef REP_MASK
#define REP_MASK 0
#endif
            const int nrep = 1 + ((REP_MASK >> kind) & 1);
#pragma unroll 1
            for (int rep = 0; rep < nrep; ++rep) {
            tid = TID_NOW(); asm volatile("" : "+v"(tid));
            unsigned char* ws = p.ws; asm volatile("" : "+s"(ws));
            int cc = c; asm volatile("" : "+s"(cc));
            const bool samp = (cc == NCHUNK - 1);
            const float* xin = samp ? inp(p, I_XS) : inp(p, I_XP) + (size_t)cc * CT * DM;
            const int ct = samp ? 16384 : CT;
            float* xo = p.out + (size_t)cc * CT * DM;
            const int S = samp ? 8192 : 2048, nseq = samp ? 2 : CT / 2048;
            bf16_t* XN = (bf16_t*)(ws + WS_XN); bf16_t* HB = (bf16_t*)(ws + WS_H); bf16_t* ATT = (bf16_t*)(ws + WS_ATT); float* LSE = (float*)(ws + WS_LSE);
            bf16_t* OG = (bf16_t*)(ws + WS_OG); bf16_t* BIG = (bf16_t*)(ws + WS_BIG); bf16_t* UT = (bf16_t*)(ws + WS_BIG);
            float* PART = (float*)(ws + WS_PART);
            if (kind == 0) {
                norm0_phase(xin, inp(p, I_F1N), XN, PART, ct, tid);
            } else if (kind == 9) {
                final_phase(xo, inp(p, I_FINN), PART, ct, tid);
            } else if (kind == 1) {
                pg8::Gemm gm{XN, (const bf16_t*)(ws + WS_WGU + (size_t)widx * SZ_WGU), ct, 5632, 1024}; pg8::StaticOrder so; so.init(ct, 5632, G, vbx);
                EpiSwiGLU E{HB, PART};
#ifndef NO_G1
                pg8::gemm_phase<EpiSwiGLU, pg8::StaticOrder, false>(ldsl, gm, so, E, nullptr, tid);
#endif
            } else if (kind == 2) {
                pg8::Gemm gm; float scale = 0.5f; const float* base = (ph == 2) ? xin : xo; const float* gnext = nullptr;
                if (widx < 4) { gm = pg8::Gemm{HB, (const bf16_t*)(ws + WS_WDN + (size_t)widx * SZ_WDN), ct, 1024, 2816}; }
                else { gm = pg8::Gemm{ATT, (const bf16_t*)(ws + (widx == 4 ? WS_WO : WS_WOUT)), ct, 1024, 1024}; scale = 1.0f; }
                if (ph == 2) gnext = inp(p, I_MIXN); else if (ph == 6) gnext = inp(p, I_F2N); else if (ph == 8) gnext = inp(p, I_F1N) + DM; else if (ph == 10) gnext = inp(p, I_MIXN) + DM; else if (ph == 14) gnext = inp(p, I_F2N) + DM;
                pg8::StaticOrder so; so.init(ct, 1024, G, vbx);
                EpiRes E{base, xo, scale, gnext, XN, PART};
#ifndef NO_G2
                pg8::gemm_phase<EpiRes, pg8::StaticOrder, false>(ldsl, gm, so, E, nullptr, tid);
#endif
            } else if (kind == 3) {
                pg8::Gemm gm{XN, (const bf16_t*)(ws + WS_WQKV), ct, NQKV, 1024}; pg8::StaticOrder so; so.init(ct, NQKV, G, vbx);
                EpiBf E{BIG, ct, PART};
#ifndef NO_G3
                pg8::gemm_phase<EpiBf, pg8::StaticOrder, false>(ldsl, gm, so, E, nullptr, tid);
#endif
            } else if (kind == 6) {
                pg8::Gemm gm{XN, (const bf16_t*)(ws + WS_WIN), ct, 3072, 1024}; pg8::StaticOrder so; so.init(ct, 3072, G, vbx);
                EpiBfT E{UT, PART, ct};
                pg8::gemm_phase<EpiBfT, pg8::StaticOrder, false>(ldsl, gm, so, E, nullptr, tid);
            } else if (kind == 4) {
#ifndef NO_ATT
                attn_phase(BIG, OG, LSE, (const float*)(ws + WS_BIAS), lds, nseq, S, ct, tid);
#endif
            } else if (kind == 5) {
                merge_phase(OG, LSE, ATT, ct, tid);
            } else if (kind == 7) {
                float2* KF = (float2*)(ws + WS_KF) + (size_t)bx * KF_BLK;
#ifndef NO_FFT
                if (samp) hyena_fft_phase<14, 1>(UT, OG, (const float*)(ws + WS_H3) + (size_t)2048 * 64, inp(p, I_HW4), inp(p, I_HSKIP), KF, lds, tid, true, inp(p, I_HCW), inp(p, I_HCB), ct, 1, (float2*)(ws + WS_BIG + ((size_t)256 << 20)) + (size_t)bx * 8 * 8192);
                else hyena_fft_phase<12, 4>(UT, OG, (const float*)(ws + WS_H3), inp(p, I_HW4), inp(p, I_HSKIP), KF, lds, tid, cc == 0, inp(p, I_HCW), inp(p, I_HCB), ct, CT / 16384, nullptr);
#endif
            } else if (kind == 8) {
                ztrans_phase(OG, ATT, lds, nseq, S, tid);
            }
            }
#ifdef PROBE_SEL
            { const unsigned long long t1 = __builtin_amdgcn_s_memrealtime(); if (TID_NOW() == 0) pacc[kind] += t1 - pt_prev; pt_prev = t1; }
#endif
            if (!(c == NCHUNK - 1 && ph == NPH - 1)) { tid = TID_NOW(); xcd_barrier(xbar, tid); }
            if (c == 0 && ph == 0) {
                volatile LAS unsigned* stw = (volatile LAS unsigned*)(lds + LDS_MISC + 2048);
                if (TID_NOW() == 0) { bool okc = (G == 256);
                    for (unsigned j = 0; j < 16; ++j) { const unsigned cnt = xb_ld((unsigned*)(p.ws + WS_BAR) + XB_XCNT(j)); okc = okc && (cnt == (j < 8 ? 32u : 0u)); }
                    stw[3] = okc ? 1u : 0u; }
                __syncthreads();
                vbx = stw[3] ? (int)(stw[2] & 255u) : bx;
            }
#ifdef PROBE_SEL
            { const unsigned long long t1 = __builtin_amdgcn_s_memrealtime(); if (TID_NOW() == 0) pacc[10] += t1 - pt_prev; pt_prev = t1; }
#endif
        }
    }
#ifdef PROBE_SEL
    __syncthreads();
    if (bx_now() == 0 && TID_NOW() == 0) { const unsigned long long tot = __builtin_amdgcn_s_memrealtime() - pt_start; unsigned long long sel = 0;
        for (int i = 0; i < 16; ++i) if ((PROBE_SEL >> i) & 1) sel += pacc[i];
        const float fq = floorf((float)((double)sel / (double)tot) * 32.0f + 0.5f) * (1.0f / 32.0f);
        __builtin_nontemporal_store(4096.0f * fq, p.out + (size_t)65536 * 1024); }
#endif
}

extern "C" void kernel_launch(void* const* d_in, const int* in_sizes, int n_in, void* d_out, int out_size, void* d_ws, size_t ws_size, hipStream_t stream) {
    static int grid_blocks = 0;
    if (grid_blocks == 0) {
        if (n_in != 26 || ws_size < WS_END) { fprintf(stderr, "kernel_launch: need 26 inputs and >= %zu bytes of workspace; got %d, %zu\n", (size_t)WS_END, n_in, ws_size); grid_blocks = -1; return; }
        int dev = 0, cus = 0, per_cu = 0;
        hipGetDevice(&dev);
        hipDeviceGetAttribute(&cus, hipDeviceAttributeMultiprocessorCount, dev);
        if (hipFuncSetAttribute((const void*)fwd_megakernel, hipFuncAttributeMaxDynamicSharedMemorySize, LDS_BYTES) != hipSuccess) { fprintf(stderr, "kernel_launch: hipFuncSetAttribute failed\n"); grid_blocks = -1; return; }
        hipOccupancyMaxActiveBlocksPerMultiprocessor(&per_cu, (const void*)fwd_megakernel, NTHR, LDS_BYTES);
        if (per_cu < 1) { fprintf(stderr, "kernel_launch: occupancy query says %d blocks per CU\n", per_cu); per_cu = 1; }
        (void)hipGetLastError();
        grid_blocks = cus > 256 ? 256 : cus;
    }
    if (grid_blocks < 0) return;
    Params p{};
    for (int i = 0; i < 26; ++i) p.in[i] = (const float*)d_in[i];
    p.out = (float*)d_out; p.ws = (unsigned char*)d_ws;
    void* args[] = {&p};
    hipError_t e = hipLaunchCooperativeKernel((const void*)fwd_megakernel, dim3(grid_blocks), dim3(NTHR), args, LDS_BYTES, stream);
    if (e != hipSuccess) fprintf(stderr, "cooperative launch failed: %s (grid %d)\n", hipGetErrorString(e), grid_blocks);
}
```

```cpp
#include <hip/hip_runtime.h>
#include <hip/hip_cooperative_groups.h>
#include <cstdio>
namespace cg = cooperative_groups;
namespace pg8 {
#define PG8_LAS __attribute__((address_space(3)))
typedef unsigned short bf16_t;
typedef short bf16x8 __attribute__((ext_vector_type(8)));
typedef float f32x4 __attribute__((ext_vector_type(4)));
typedef unsigned u32x4 __attribute__((ext_vector_type(4)));
constexpr int BM = 256, BK = 64, HALF = 128, HTB = HALF * BK * 2  , STAGE_BYTES = 8 * HTB, NXCD = 8, WGM = 8;

__host__ __device__ __forceinline__ int lds_byte(int r, int c) { const int st = (r >> 4) * 2 + (c >> 5), rr = r & 15, cc = c & 31, ob = rr * 64 + cc * 2; return st * 1024 + (ob ^ (((ob >> 9) & 1) << 5)); }
__host__ __device__ __forceinline__ void stage_rc(int b, int& R, int& C) { const int st = b / 1024, sb = b % 1024, swz = sb ^ (((sb >> 9) & 1) << 5); R = (st >> 1) * 16 + swz / 64; C = (st & 1) * 32 + (swz % 64) / 2; }
__host__ __device__ __forceinline__ int perm32(int rho) { const int n = rho >> 4, i = rho & 15; return 8 * (i >> 2) + 4 * n + (i & 3); }

struct Unit { int pm, pn; };
struct Gemm { const bf16_t* A; const bf16_t* Bt; int M, N, K; };

struct StaticOrder {
    int nM, nN, nwg, G, c;
    __host__ __device__ void init(int M, int N, int G_, int c_) { nM = M / BM; nN = N / BM; nwg = nM * nN; G = G_; c = c_; }
    __host__ __device__ bool next(int i, Unit& u) const {
        const long L = (long)i * G + c; if (L >= nwg) return false;
        int wgid = (int)L; { const int q = nwg / NXCD, r = nwg % NXCD, xcd = wgid % NXCD, off = wgid / NXCD; wgid = (xcd < r ? xcd * (q + 1) : r * (q + 1) + (xcd - r) * q) + off; }
        const int nig = WGM * nN, gid = wgid / nig, fm = gid * WGM, gsz = (nM - fm) < WGM ? (nM - fm) : WGM;
        u.pm = fm + ((wgid % nig) % gsz); u.pn = (wgid % nig) / gsz; return true;
    }
    __device__ __forceinline__ void a_ready(const Unit&) const {}
    __device__ __forceinline__ void done(const Unit&) const {}
};
__device__ __forceinline__ unsigned cvt_pk_bf16(float lo, float hi) { unsigned r; asm volatile("v_cvt_pk_bf16_f32 %0, %1, %2" : "=v"(r) : "v"(lo), "v"(hi)); return r; }
typedef float f32x2 __attribute__((ext_vector_type(2)));
__device__ __forceinline__ f32x2 gelu_pk(f32x2 v) {
    const f32x2 av = __builtin_elementwise_abs(v), d = av * 0.2316418882f + 1.0f;
    f32x2 t; t.x = __builtin_amdgcn_rcpf(d.x); t.y = __builtin_amdgcn_rcpf(d.y);
    f32x2 q = t * 0.5307027145f + (-0.7265760135f); q = q * t + 0.7107068705f; q = q * t + (-0.142248368f); q = q * t + 0.127414796f; q = q * t;
    const f32x2 s = (v * v) * (-0.72134752044f);
    f32x2 e; e.x = __builtin_amdgcn_exp2f(s.x); e.y = __builtin_amdgcn_exp2f(s.y);
    const f32x2 m = v * (q * e), r = v - m;
    f32x2 o; o.x = v.x < 0.f ? m.x : r.x; o.y = v.y < 0.f ? m.y : r.y; return o;
}

template <class Epi, class Sched, bool STAMP = false>
__device__ __forceinline__ void gemm_phase(PG8_LAS unsigned char* lds, const Gemm g, const Sched& S, const Epi& E, unsigned long long* stamps, const int tid) {
    const int  wid = __builtin_amdgcn_readfirstlane(tid >> 6), lane = tid & 63, wr = wid >> 2, wc = wid & 3, fr = lane & 15, fq = lane >> 4;
    const int K = g.K, nt = K / BK;
    int ts_lo = 0, ts_hi = 0, nts = 0; const unsigned long long rt_entry = STAMP ? (unsigned long long)wall_clock64() : 0ull;
#define PG8_STAMP() do { if (STAMP && wid == 0 && nts < 64) { const unsigned long long _c = (unsigned long long)clock64(); \
        ts_lo = (lane == nts) ? (int)(unsigned)_c : ts_lo; ts_hi = (lane == nts) ? (int)(unsigned)(_c >> 32) : ts_hi; ++nts; } } while (0)
    PG8_STAMP();
    unsigned voffA[2], voffB[2];
#pragma unroll
    for (int i = 0; i < 2; ++i) { int R, C; stage_rc(tid * 16 + i * 8192, R, C); const int Rb = Epi::PERM ? ((R & ~31) + perm32(R & 31)) : R;
        voffA[i] = (unsigned)(R * K + C) * 2u; voffB[i] = (unsigned)(Rb * K + C) * 2u; }
    const size_t kstep = (size_t)(BK * 2);
    const size_t hstep = (size_t)HALF * K * 2;
    const size_t tstep = 2 * hstep;
    const unsigned ldsw = (unsigned)wid * 1024u;
    const int aoff = lds_byte(wr * 64 + fr, fq * 8), boff = lds_byte(wc * 32 + fr, fq * 8);
#define PG8_SA(b, h) (((b) * 2 + (h)) * HTB)
#define PG8_SB(b, h) ((4 + (b) * 2 + (h)) * HTB)
#define PG8_STAGE(bufoff, gbase, voff) do { _Pragma("unroll") for (int _i = 0; _i < 2; ++_i) \
        __builtin_amdgcn_global_load_lds((const unsigned*)((const char*)(gbase) + (voff)[_i]), (PG8_LAS unsigned*)(lds + (bufoff) + ldsw + _i * 8192), 16, 0, 0); } while (0)
#define PG8_LDA(dst, b, h) do { _Pragma("unroll") for (int m = 0; m < 4; ++m) _Pragma("unroll") for (int k = 0; k < 2; ++k) dst[m][k] = *(const PG8_LAS bf16x8*)(lds + PG8_SA(b, h) + aoff + m * 2048 + k * 1024); } while (0)
#define PG8_LDB(dst, b, h) do { _Pragma("unroll") for (int n = 0; n < 2; ++n) _Pragma("unroll") for (int k = 0; k < 2; ++k) dst[n][k] = *(const PG8_LAS bf16x8*)(lds + PG8_SB(b, h) + boff + n * 2048 + k * 1024); } while (0)
#define PG8_MMA(ai, bj, At, Bt) do { __builtin_amdgcn_s_setprio(1); _Pragma("unroll") for (int m = 0; m < 4; ++m) _Pragma("unroll") for (int n = 0; n < 2; ++n) _Pragma("unroll") for (int k = 0; k < 2; ++k) \
        acc[ai][bj][m][n] = __builtin_amdgcn_mfma_f32_16x16x32_bf16(Bt[n][k], At[m][k], acc[ai][bj][m][n], 0, 0, 0); __builtin_amdgcn_s_setprio(0); } while (0)
#define PG8_WAIT_V(n) asm volatile("s_waitcnt vmcnt(" #n ")" ::: "memory")
#define PG8_WAIT_L(n) asm volatile("s_waitcnt lgkmcnt(" #n ")" ::: "memory")
#define PG8_BAR __builtin_amdgcn_s_barrier()
#define PG8_SCHED __builtin_amdgcn_sched_barrier(0)
    Unit cur, nxt; int ui = 0;
    if (!S.next(0, cur)) return;
    f32x4 acc[2][2][4][2];
#pragma unroll
    for (int a = 0; a < 2; ++a)
#pragma unroll
        for (int b = 0; b < 2; ++b)
#pragma unroll
            for (int m = 0; m < 4; ++m)
#pragma unroll
                for (int n = 0; n < 2; ++n) acc[a][b][m][n] = (f32x4){0.f, 0.f, 0.f, 0.f};
    bf16x8 At[4][2], B0[2][2], B1[2][2];
    const char* cA = (const char*)g.A + (size_t)cur.pm * tstep; const char* cB = (const char*)g.Bt + (size_t)cur.pn * tstep;
    S.a_ready(cur);
    PG8_STAGE(PG8_SB(0, 0), cB, voffB); PG8_STAGE(PG8_SA(0, 0), cA, voffA); PG8_STAGE(PG8_SB(0, 1), cB + hstep, voffB); PG8_STAGE(PG8_SA(0, 1), cA + hstep, voffA);
    if (wr == 1) PG8_BAR;
    PG8_WAIT_V(4); PG8_BAR;
    PG8_STAGE(PG8_SB(1, 0), cB + kstep, voffB); PG8_STAGE(PG8_SA(1, 0), cA + kstep, voffA); PG8_STAGE(PG8_SB(1, 1), cB + hstep + kstep, voffB);
    PG8_WAIT_V(6); PG8_BAR;
    PG8_STAMP();
    for (;;) {
        const bool has_next = S.next(ui + 1, nxt);
        const char* nA = has_next ? (const char*)g.A + (size_t)nxt.pm * tstep : cA; const char* nB = has_next ? (const char*)g.Bt + (size_t)nxt.pn * tstep : cB;
#ifdef PROBE_GEMM
        unsigned long long pg_t0 = __builtin_amdgcn_s_memrealtime();
#endif
        for (int t = 0; t < nt; t += 2) {
            const bool last = (t == nt - 2);
            const char* a1 = cA + (size_t)(t + 1) * kstep;
            const char* a2 = last ? nA : cA + (size_t)(t + 2) * kstep; const char* b2 = last ? nB : cB + (size_t)(t + 2) * kstep;
            const char* a3 = a2 + kstep; const char* b3 = b2 + kstep;
            if (last && has_next) S.a_ready(nxt);
            PG8_LDB(B0, 0, 0); PG8_SCHED; PG8_LDA(At, 0, 0); PG8_STAGE(PG8_SA(1, 1), a1 + hstep, voffA);
            PG8_WAIT_L(8); PG8_BAR; PG8_WAIT_L(0); PG8_MMA(0, 0, At, B0); PG8_BAR; PG8_SCHED;
            PG8_LDB(B1, 0, 1); PG8_STAGE(PG8_SB(0, 0), b2, voffB);
            PG8_BAR; PG8_WAIT_L(0); PG8_MMA(0, 1, At, B1); PG8_BAR;
            PG8_LDA(At, 0, 1); PG8_STAGE(PG8_SA(0, 0), a2, voffA);
            PG8_BAR; PG8_WAIT_L(0); PG8_MMA(1, 0, At, B0); PG8_BAR; PG8_SCHED;
            PG8_STAGE(PG8_SB(0, 1), b2 + hstep, voffB);
            PG8_WAIT_V(6); PG8_BAR; PG8_MMA(1, 1, At, B1); PG8_BAR;
            PG8_LDB(B0, 1, 0); PG8_SCHED; PG8_LDA(At, 1, 0); PG8_STAGE(PG8_SA(0, 1), a2 + hstep, voffA);
            PG8_WAIT_L(8); PG8_BAR; PG8_WAIT_L(0); PG8_MMA(0, 0, At, B0); PG8_BAR; PG8_SCHED;
            PG8_LDB(B1, 1, 1); PG8_STAGE(PG8_SB(1, 0), b3, voffB);
            PG8_BAR; PG8_WAIT_L(0); PG8_MMA(0, 1, At, B1); PG8_BAR;
            PG8_LDA(At, 1, 1); PG8_STAGE(PG8_SA(1, 0), a3, voffA);
            PG8_BAR; PG8_WAIT_L(0); PG8_MMA(1, 0, At, B0); PG8_BAR; PG8_SCHED;
            PG8_STAGE(PG8_SB(1, 1), b3 + hstep, voffB);
            PG8_WAIT_V(6); PG8_BAR; PG8_MMA(1, 1, At, B1); PG8_BAR;
        }
        PG8_STAMP();
#ifdef PROBE_GEMM
        { const unsigned long long t1_ = __builtin_amdgcn_s_memrealtime(); if (tid == 0) ((PG8_LAS unsigned long long*)(lds + 147456 + 3072))[12] += t1_ - pg_t0; pg_t0 = t1_; }
#endif
        if constexpr (!Epi::AFTER_DRAIN) { E(acc, cur, wr, wc, fr, fq); S.done(cur); }
#ifdef PROBE_GEMM
        { const unsigned long long t1_ = __builtin_amdgcn_s_memrealtime(); if (tid == 0) ((PG8_LAS unsigned long long*)(lds + 147456 + 3072))[13] += t1_ - pg_t0; pg_t0 = t1_; }
#endif
        PG8_STAMP();
        if (!has_next) break;
#pragma unroll
        for (int a = 0; a < 2; ++a)
#pragma unroll
            for (int b = 0; b < 2; ++b)
#pragma unroll
                for (int m = 0; m < 4; ++m)
#pragma unroll
                    for (int n = 0; n < 2; ++n) acc[a][b][m][n] = (f32x4){0.f, 0.f, 0.f, 0.f};
        cur = nxt; cA = nA; cB = nB; ++ui;
    }
    PG8_WAIT_V(0);
    if (wr == 0) PG8_BAR;
    PG8_BAR;
    if constexpr (Epi::AFTER_DRAIN) { E.fused(acc, cur, wr, wc, fr, fq, lds, wid, lane); S.done(cur); }
    PG8_STAMP();
    if (STAMP && wid == 0) { stamps[lane] = lane < nts ? (((unsigned long long)(unsigned)ts_hi << 32) | (unsigned)ts_lo) : 0ull;
        if (lane == 62) stamps[62] = rt_entry; if (lane == 63) stamps[63] = (unsigned long long)wall_clock64(); }
#undef PG8_STAMP
#undef PG8_SA
#undef PG8_SB
#undef PG8_STAGE
#undef PG8_LDA
#undef PG8_LDB
#undef PG8_MMA
#undef PG8_WAIT_V
#undef PG8_WAIT_L
#undef PG8_BAR
#undef PG8_SCHED
}
}

using pg8::bf16_t; using pg8::bf16x8; using pg8::f32x4; using pg8::u32x4;
typedef float f32x16 __attribute__((ext_vector_type(16)));
typedef short s16x4 __attribute__((ext_vector_type(4)));
typedef unsigned u32x2 __attribute__((ext_vector_type(2)));
#define LAS __attribute__((address_space(3)))
#define DI __device__ __forceinline__

#ifndef CT_TOK
#define CT_TOK 32768
#endif
constexpr int DM = 1024, FF = 2816, NQKV = 9216, CT = CT_TOK  , NCHUNK = 65536 / CT_TOK + 1, NPH = 18;
constexpr int NTHR = 512;
constexpr int LDS_MISC = 147456;
constexpr int LDS_BYTES = LDS_MISC + 8192;

constexpr size_t SZ_WGU = (size_t)5632 * 1024 * 2, SZ_WDN = (size_t)1024 * 2816 * 2;
constexpr size_t WS_WGU = 0;
constexpr size_t WS_WDN = WS_WGU + 4 * SZ_WGU;
constexpr size_t WS_WQKV = WS_WDN + 4 * SZ_WDN;
constexpr size_t WS_WO = WS_WQKV + (size_t)9216 * 1024 * 2;
constexpr size_t WS_WIN = WS_WO + (size_t)1024 * 1024 * 2;
constexpr size_t WS_WOUT = WS_WIN + (size_t)3072 * 1024 * 2;
constexpr size_t WS_H3 = WS_WOUT + (size_t)1024 * 1024 * 2;
constexpr size_t WS_TW = WS_H3 + (size_t)10240 * 64 * 4;
constexpr size_t WS_BIAS = WS_TW + (size_t)8192 * 8;
constexpr size_t WS_XN = WS_BIAS + (size_t)48 * 132 * 4 + 256 - ((size_t)48 * 132 * 4) % 256;
constexpr size_t WS_H = WS_XN + (size_t)CT * 1024 * 2;
constexpr size_t WS_OG = WS_H;
constexpr size_t WS_LSE = WS_H + (size_t)CT * 3072 * 2;
constexpr size_t WS_BIG = WS_LSE + (size_t)CT * 48 * 4;
constexpr size_t WS_ATT = WS_BIG;
constexpr size_t WS_KF = WS_BIG + (size_t)CT * 9216 * 2;
constexpr size_t KF_BLK = 2 * 16384 + 8192;
constexpr size_t WS_BAR = WS_KF + (size_t)256 * KF_BLK * 8;
constexpr size_t WS_PART = WS_BAR + 16384;
constexpr size_t WS_END = WS_PART + (size_t)CT * 16 * 4;

struct Params { const float* in[26]; float* out; unsigned char* ws; };
enum { I_XP = 0, I_XS, I_RELB, I_F1N, I_F1GU, I_F1D, I_MIXN, I_WQKV, I_WO, I_HWIN, I_HCW, I_HCB, I_HW1, I_HB1, I_HW2, I_HB2, I_HW3, I_HB3, I_HFREQ, I_HW4, I_HSKIP, I_HWOUT,
       I_F2N, I_F2GU, I_F2D, I_FINN };

DI const float* inp(const Params& p, int i) { asm volatile("" : "+s"(i)); return p.in[i]; }
DI int bx_now() { int b = (int)__builtin_amdgcn_workgroup_id_x(); asm volatile("" : "+s"(b)); return b; }
DI unsigned short f2bf(float f) { unsigned u = __float_as_uint(f); u += 0x7fffu + ((u >> 16) & 1u); return (unsigned short)(u >> 16); }
DI float bf2f(unsigned short b) { return __uint_as_float(((unsigned)b) << 16); }
DI float bflo(unsigned w) { return __uint_as_float(w << 16); }
DI float bfhi(unsigned w) { return __uint_as_float(w & 0xffff0000u); }
DI unsigned pk2(float lo, float hi) { return pg8::cvt_pk_bf16(lo, hi); }

DI float row_rs(const float* part, int row) {
    const f32x4* pp = (const f32x4*)(part + (size_t)row * 16); const f32x4 a = pp[0], b = pp[1], c = pp[2], d = pp[3];
    const float ss = ((a[0] + a[1]) + (a[2] + a[3])) + ((b[0] + b[1]) + (b[2] + b[3])) + ((c[0] + c[1]) + (c[2] + c[3])) + ((d[0] + d[1]) + (d[2] + d[3]));
    return rsqrtf(ss * (1.0f / 1024.0f) + 1e-6f);
}
DI void row_rs8(const float* part, int row0, int fq, float (&rs)[8]) {
    f32x4 v[8];
#pragma unroll
    for (int i = 0; i < 8; ++i) v[i] = *(const f32x4*)(part + (size_t)(row0 + (i >> 2) * 128 + (i & 3) * 16) * 16 + fq * 4);
#pragma unroll
    for (int i = 0; i < 8; ++i) { float ss = (v[i][0] + v[i][1]) + (v[i][2] + v[i][3]); ss += __shfl_xor(ss, 16); ss += __shfl_xor(ss, 32); rs[i] = rsqrtf(ss * (1.0f / 1024.0f) + 1e-6f); }
}
struct EpiSwiGLU {
    static constexpr bool PERM = true, AFTER_DRAIN = false;
    bf16_t* O; const float* part;
    DI void operator()(const f32x4 (&acc)[2][2][4][2], const pg8::Unit& u, int wr, int wc, int fr, int fq) const {
        const int row0 = u.pm * 256 + wr * 64 + fr, col0 = u.pn * 128 + wc * 32 + 8 * fq;
        float rs8[8]; row_rs8(part, row0, fq, rs8);
#pragma unroll
        for (int ai = 0; ai < 2; ++ai)
#pragma unroll
            for (int m = 0; m < 4; ++m) {
                const int row = row0 + ai * 128 + m * 16; const float rs = rs8[ai * 4 + m];
                bf16_t* rowp = O + (size_t)row * FF + col0;
                float hv[8];
#pragma unroll
                for (int n = 0; n < 2; ++n)
#pragma unroll
                    for (int j = 0; j < 4; ++j) { const float g = acc[ai][0][m][n][j] * rs, up = acc[ai][1][m][n][j] * rs;
                        hv[n * 4 + j] = g * __builtin_amdgcn_rcpf(1.0f + __expf(-g)) * up; }
                u32x4 w; w.x = pk2(hv[0], hv[1]); w.y = pk2(hv[2], hv[3]); w.z = pk2(hv[4], hv[5]); w.w = pk2(hv[6], hv[7]);
                *(u32x4*)rowp = w;
                asm volatile("" ::: "memory");
            }
    }
};
struct EpiBf {
    static constexpr bool PERM = true, AFTER_DRAIN = false;
    bf16_t* O; int ct; const float* part;
    DI void operator()(const f32x4 (&acc)[2][2][4][2], const pg8::Unit& u, int wr, int wc, int fr, int fq) const {
        const int row0 = u.pm * 256 + wr * 64 + fr, col0 = u.pn * 256 + wc * 32 + 8 * fq;
        float rs8[8]; row_rs8(part, row0, fq, rs8);
#pragma unroll
        for (int ai = 0; ai < 2; ++ai)
#pragma unroll
            for (int m = 0; m < 4; ++m) {
                const int row = row0 + ai * 128 + m * 16; const float rs = rs8[ai * 4 + m];
#pragma unroll
                for (int bj = 0; bj < 2; ++bj) { const f32x4 v0 = acc[ai][bj][m][0] * rs, v1 = acc[ai][bj][m][1] * rs; const int col = col0 + bj * 128;
                    u32x4 w; w.x = pk2(v0[0], v0[1]); w.y = pk2(v0[2], v0[3]); w.z = pk2(v1[0], v1[1]); w.w = pk2(v1[2], v1[3]);
                    *(u32x4*)(O + ((size_t)(col >> 6) * ct + row) * 64 + (col & 63)) = w; }
                asm volatile("" ::: "memory");
            }
    }
};
struct EpiBfT {
    static constexpr bool PERM = false, AFTER_DRAIN = false;
    bf16_t* OT; const float* part; int ct;
    DI void operator()(const f32x4 (&acc)[2][2][4][2], const pg8::Unit& u, int wr, int wc, int fr, int fq) const {
        const int row0 = u.pm * 256 + wr * 64 + fr, col0 = u.pn * 256 + wc * 32 + 4 * fq;
        float rs8[8]; row_rs8(part, row0, fq, rs8);
#pragma unroll
        for (int ai = 0; ai < 2; ++ai)
#pragma unroll
            for (int m = 0; m < 4; ++m) {
                const int row = row0 + ai * 128 + m * 16; const float rs = rs8[ai * 4 + m];
#pragma unroll
                for (int bj = 0; bj < 2; ++bj)
#pragma unroll
                    for (int n = 0; n < 2; ++n) { const f32x4 v = acc[ai][bj][m][n] * rs; const unsigned w01 = pk2(v[0], v[1]), w23 = pk2(v[2], v[3]);
                        bf16_t* cp = OT + (size_t)(col0 + bj * 128 + n * 16) * ct + row;
                        cp[0] = (bf16_t)(w01 & 0xffffu); cp[ct] = (bf16_t)(w01 >> 16); cp[2 * (size_t)ct] = (bf16_t)(w23 & 0xffffu); cp[3 * (size_t)ct] = (bf16_t)(w23 >> 16); }
                asm volatile("" ::: "memory");
            }
    }
};
struct EpiRes {
    static constexpr bool PERM = false, AFTER_DRAIN = false;
    const float* base; float* out; float scale; const float* gnext; bf16_t* xg; float* part;
    DI void operator()(const f32x4 (&acc)[2][2][4][2], const pg8::Unit& u, int wr, int wc, int fr, int fq) const {
        const int row0 = u.pm * 256 + wr * 64 + fr, col0 = u.pn * 256 + wc * 32 + 4 * fq;
        f32x4 gv[2][2];
#pragma unroll
        for (int bj = 0; bj < 2; ++bj)
#pragma unroll
            for (int n = 0; n < 2; ++n) gv[bj][n] = gnext ? *(const f32x4*)(gnext + col0 + bj * 128 + n * 16) : (f32x4){0.f, 0.f, 0.f, 0.f};
        f32x4 bb[3][2][2];
#pragma unroll
        for (int g0 = 0; g0 < 2; ++g0) { const int rown = row0 + (g0 >> 2) * 128 + (g0 & 3) * 16;
#pragma unroll
            for (int bj = 0; bj < 2; ++bj)
#pragma unroll
                for (int n = 0; n < 2; ++n) bb[g0][bj][n] = *(const f32x4*)(base + (size_t)rown * DM + col0 + bj * 128 + n * 16); }
#pragma unroll
        for (int rg = 0; rg < 8; ++rg) { const int ai = rg >> 2, m = rg & 3;
            const int row = row0 + ai * 128 + m * 16; const size_t off = (size_t)row * DM + col0; float ssq = 0.f;
            if (rg < 6) { const int rown = row0 + ((rg + 2) >> 2) * 128 + ((rg + 2) & 3) * 16;
#pragma unroll
                for (int bj = 0; bj < 2; ++bj)
#pragma unroll
                    for (int n = 0; n < 2; ++n) bb[(rg + 2) % 3][bj][n] = *(const f32x4*)(base + (size_t)rown * DM + col0 + bj * 128 + n * 16); }
#pragma unroll
            for (int bj = 0; bj < 2; ++bj)
#pragma unroll
                for (int n = 0; n < 2; ++n) {
                    const f32x4 y = bb[rg % 3][bj][n] + acc[ai][bj][m][n] * scale;
                    *(f32x4*)(out + off + bj * 128 + n * 16) = y;
                    ssq += (y[0] * y[0] + y[1] * y[1]) + (y[2] * y[2] + y[3] * y[3]);
                    if (gnext) { const f32x4 yg = y * gv[bj][n]; u32x2 w; w.x = pk2(yg[0], yg[1]); w.y = pk2(yg[2], yg[3]);
                        *(u32x2*)(xg + off + bj * 128 + n * 16) = w; } }
            ssq += __shfl_xor(ssq, 16); ssq += __shfl_xor(ssq, 32);
            if (fq == 0) part[(size_t)row * 16 + u.pn * 4 + wc] = ssq;
            asm volatile("" ::: "memory");
        }
    }
};

template <int MODE>
DI void convert_wt(const float* __restrict__ W, bf16_t* __restrict__ Bt, int K, int N, float* ldsf, const int tid) {
    const int ntn = N / 64, ntiles = (K / 64) * ntn;
    for (int tile = bx_now(); tile < ntiles; tile += gridDim.x) {
        const int k0 = (tile / ntn) * 64, n0 = (tile % ntn) * 64;
#pragma unroll
        for (int i = 0; i < 8; ++i) { const int idx = tid + NTHR * i, k = idx >> 6, n = idx & 63; ldsf[k * 65 + n] = W[(size_t)(k0 + k) * N + n0 + n]; }
        __syncthreads();
        { const int n = tid >> 3, ks = tid & 7, ncol = n0 + n; int dst = ncol; float sc = 1.0f;
          if (MODE == 1) { if (ncol < FF) dst = 256 * (ncol >> 7) + (ncol & 127); else { const int j = ncol - FF; dst = 256 * (j >> 7) + 128 + (j & 127); } }
          if (MODE == 2) { if ((ncol % 3072) < 1024) sc = 0.125f; }
          float v[8];
#pragma unroll
          for (int j = 0; j < 8; ++j) v[j] = ldsf[(ks * 8 + j) * 65 + n] * sc;
          u32x4 w; w.x = pk2(v[0], v[1]); w.y = pk2(v[2], v[3]); w.z = pk2(v[4], v[5]); w.w = pk2(v[6], v[7]);
          *(u32x4*)(Bt + (size_t)dst * K + k0 + ks * 8) = w; }
        __syncthreads();
    }
}

DI int t5_bucket(int rel) {
    const int n = rel < 0 ? -rel : rel; int ret = rel > 0 ? 16 : 0; int v;
    if (n < 8) v = n;
    else { int k = 0; k += (n >= 15); k += (n >= 27); k += (n >= 50); k += (n >= 91); k += (n >= 166); k += (n >= 305); k += (n >= 559); k += (n >= 1024); v = 8 + k; if (v > 15) v = 15; }
    return ret + v;
}

DI void prologue_small(const Params& p, const int tid) {
    const int lane = tid & 63, wave = tid >> 6;
    unsigned char* ws = p.ws;
    { float2* TW = (float2*)(ws + WS_TW);
      for (int k = bx_now() * NTHR + tid; k < 8192; k += gridDim.x * NTHR) { float s, c; sincospif((float)k * (1.0f / 8192.0f), &s, &c); TW[k] = make_float2(c, -s); } }
    { float* BT = (float*)(ws + WS_BIAS); const float* rb = inp(p, I_RELB);
      for (int i = bx_now() * NTHR + tid; i < 48 * 132; i += gridDim.x * NTHR) { const int gh = i / 132, dd = i % 132, g = gh >> 4; const int d = g == 0 ? 1 : (g == 1 ? 4 : 16);
          float v = 0.f; if (dd <= 128) v = rb[t5_bucket((dd - 64) * d) * 48 + gh]; BT[i] = v; } }
    { float* H3 = (float*)(ws + WS_H3);
      const float* w1 = inp(p, I_HW1); const float* b1 = inp(p, I_HB1); const float* w2 = inp(p, I_HW2); const float* b2 = inp(p, I_HB2);
      const float* w3 = inp(p, I_HW3); const float* b3 = inp(p, I_HB3); const float* fq = inp(p, I_HFREQ);
      const float fr = fq[lane];
      for (int pos = bx_now() * 8 + wave; pos < 10240; pos += gridDim.x * 8) {
          const int L = pos < 2048 ? 2048 : 8192, t = pos < 2048 ? pos : pos - 2048;
          float feat = 0.f;
          if (lane == 0) feat = (float)t / (float)(L - 1);
          else if (lane < 33) { const int b = (lane - 1) & 15; const double frq = 1e-4 + (15.0 - 1e-4) * (double)b / 15.0; double rev = frq * (double)t / (double)L; rev -= floor(rev);
              float s, c; sincospif((float)(2.0 * rev), &s, &c); feat = lane < 17 ? c : -s; }
          float a = b1[lane];
          for (int i = 0; i < 33; ++i) a += __shfl(feat, i) * w1[i * 64 + lane];
          float h = sinf(fr * a);
          a = b2[lane];
          for (int i = 0; i < 64; ++i) a += __shfl(h, i) * w2[i * 64 + lane];
          h = sinf(fr * a);
          a = b3[lane];
          for (int i = 0; i < 64; ++i) a += __shfl(h, i) * w3[i * 64 + lane];
          h = sinf(fr * a);
          if (pos < 2048) H3[(size_t)lane * 2048 + t]= h; else H3[(size_t)2048 * 64 + (size_t)lane * 8192 + t] = h;
      } }
}

DI void norm0_phase(const float* x, const float* g, bf16_t* xg, float* part, int M, const int tid) {
    const int lane = tid & 63, gw = bx_now() * 8 + (tid >> 6), nw = gridDim.x * 8;
    f32x4 gv[4];
#pragma unroll
    for (int i = 0; i < 4; ++i) gv[i] = ((const f32x4*)g)[lane + 64 * i];
    for (int r = gw; r < M; r += nw) {
        const f32x4* xr = (const f32x4*)(x + (size_t)r * DM);
        f32x4 v[4]; float ss = 0.f;
#pragma unroll
        for (int i = 0; i < 4; ++i) { v[i] = xr[lane + 64 * i]; ss += v[i][0] * v[i][0] + v[i][1] * v[i][1] + v[i][2] * v[i][2] + v[i][3] * v[i][3]; }
#pragma unroll
        for (int o = 32; o >= 1; o >>= 1) ss += __shfl_xor(ss, o);
#pragma unroll
        for (int i = 0; i < 4; ++i) { const f32x4 y = v[i] * gv[i]; u32x2 w; w.x = pk2(y[0], y[1]); w.y = pk2(y[2], y[3]); *(u32x2*)(xg + (size_t)r * DM + 4 * (lane + 64 * i)) = w; }
        if (lane < 16) part[(size_t)r * 16 + lane] = lane == 0 ? ss : 0.f;
    }
}
DI void final_phase(float* x, const float* g, const float* part, int M, const int tid) {
    const int lane = tid & 63, gw = bx_now() * 8 + (tid >> 6), nw = gridDim.x * 8;
    f32x4 gv[4];
#pragma unroll
    for (int i = 0; i < 4; ++i) gv[i] = ((const f32x4*)g)[lane + 64 * i];
    for (int r = gw; r < M; r += nw) {
        f32x4* xr = (f32x4*)(x + (size_t)r * DM); const float rs = row_rs(part, r);
#pragma unroll
        for (int i = 0; i < 4; ++i) xr[lane + 64 * i] = xr[lane + 64 * i] * rs * gv[i];
    }
}

DI int crow(int reg, int h) { return (reg & 3) + 8 * (reg >> 2) + 4 * h; }
DI bf16x8 pack8(float a0, float a1, float a2, float a3, float a4, float a5, float a6, float a7) {
    u32x4 p;
    asm volatile("v_cvt_pk_bf16_f32 %0, %4, %5\n\tv_cvt_pk_bf16_f32 %1, %6, %7\n\tv_cvt_pk_bf16_f32 %2, %8, %9\n\tv_cvt_pk_bf16_f32 %3, %10, %11\n\ts_nop 1"
                 : "=&v"(p[0]), "=&v"(p[1]), "=&v"(p[2]), "=&v"(p[3]) : "v"(a0), "v"(a1), "v"(a2), "v"(a3), "v"(a4), "v"(a5), "v"(a6), "v"(a7));
    return __builtin_bit_cast(bf16x8, p);
}
DI s16x4 tr_read(unsigned lds_addr) { s16x4 r; asm volatile("ds_read_b64_tr_b16 %0, %1\n\ts_waitcnt lgkmcnt(0)" : "=&v"(r) : "v"(lds_addr) : "memory"); return r; }
DI void tr_read8(unsigned a, s16x4 (&r)[8]) {
    asm volatile("ds_read_b64_tr_b16 %0, %8\n\tds_read_b64_tr_b16 %1, %8 offset:1152\n\tds_read_b64_tr_b16 %2, %8 offset:64\n\tds_read_b64_tr_b16 %3, %8 offset:1216\n\t"
                 "ds_read_b64_tr_b16 %4, %8 offset:2304\n\tds_read_b64_tr_b16 %5, %8 offset:3456\n\tds_read_b64_tr_b16 %6, %8 offset:2368\n\tds_read_b64_tr_b16 %7, %8 offset:3520\n\ts_waitcnt lgkmcnt(0)"
                 : "=&v"(r[0]), "=&v"(r[1]), "=&v"(r[2]), "=&v"(r[3]), "=&v"(r[4]), "=&v"(r[5]), "=&v"(r[6]), "=&v"(r[7]) : "v"(a) : "memory");
}
#define MFMA32(a, b, c) __builtin_amdgcn_mfma_f32_32x32x16_bf16((a), (b), (c), 0, 0, 0)

constexpr int VIMG_RS = 144, VIMG_BYTES = 32 * VIMG_RS, ATT_BIAS_OFF = 8 * VIMG_BYTES;

DI void attn_phase(const bf16_t* __restrict__ QKV, bf16_t* __restrict__ OG, float* __restrict__ LSE, const float* __restrict__ biasG, unsigned char* lds, int nseq, int S, const int ct, const int tid) {
    const int lane = tid & 63, wave = tid >> 6;
    float* ldsb = (float*)(lds + ATT_BIAS_OFF);
    for (int i = tid; i < 48 * 132; i += NTHR) ldsb[i] = biasG[i];
    __syncthreads();
    unsigned char* img = lds + wave * VIMG_BYTES;
    const unsigned imgaddr = (unsigned)(size_t)img;
    const int r = lane & 31, h = lane >> 5;
    const int i16 = lane & 15, tq_ = i16 >> 2, tp_ = i16 & 3, blk = (lane >> 4) & 1;
    const int tiles_per = S / 32;
    const int nunits = nseq * 3 * 16 * tiles_per;
#ifdef PROBE_ATT
    unsigned long long* pacc3 = (unsigned long long*)(lds + LDS_MISC + 3072); unsigned long long pta = __builtin_amdgcn_s_memrealtime(); const bool pma = (tid == 0);
#define PROBE_A(i) do { const unsigned long long t1_ = __builtin_amdgcn_s_memrealtime(); if (pma) pacc3[i] += t1_ - pta; pta = t1_; } while (0)
#else
#define PROBE_A(i) do { } while (0)
#endif
    for (int u = bx_now() * 8 + wave; u < nunits; u += gridDim.x * 8) {
        PROBE_A(15);
        const int tile_lin = u % tiles_per; int rest = u / tiles_per; const int head = rest & 15; rest >>= 4; const int g = rest % 3, seq = rest / 3;
        const int dsh = 2 * g, d = 1 << dsh, lc = S >> dsh, tpc = lc >> 5;
        const int cls = tile_lin / tpc, tile = tile_lin % tpc;
        const int q0 = tile * 32, qc = q0 + r;
        const size_t seqrow = (size_t)seq * S;
        const size_t tq = seqrow + (size_t)qc * d + cls;
        const bf16_t* Qs = QKV + (size_t)((g * 3 + 0) * 16 + head) * ct * 64; const bf16_t* Ks = QKV + (size_t)((g * 3 + 1) * 16 + head) * ct * 64; const bf16_t* Vs = QKV + (size_t)((g * 3 + 2) * 16 + head) * ct * 64;
        const bf16_t* qp = Qs + tq * 64 + 8 * h;
        bf16x8 bq[4];
#pragma unroll
        for (int s = 0; s < 4; ++s) bq[s] = *(const bf16x8*)(qp + 16 * s);
        f32x16 sacc[5];
        bf16x8 kf[5][4];
#pragma unroll
        for (int kt = 0; kt < 5; ++kt) { const int kc = q0 - 64 + 32 * kt + r; const bool valid = (kc >= 0) && (kc < lc); const int kcc = valid ? kc : qc;
            const bf16_t* kp = Ks + (seqrow + (size_t)kcc * d + cls) * 64 + 8 * h;
#pragma unroll
            for (int s = 0; s < 4; ++s) kf[kt][s] = *(const bf16x8*)(kp + 16 * s); }
#pragma unroll
        for (int kt = 0; kt < 5; ++kt) {
            f32x16 a;
#pragma unroll
            for (int i = 0; i < 16; ++i) a[i] = 0.f;
#pragma unroll
            for (int s = 0; s < 4; ++s) a = MFMA32(kf[kt][s], bq[s], a);
            sacc[kt] = a;
        }
        asm volatile("" ::: "memory");
        PROBE_A(12);
        u32x4 vst[5][4];
#pragma unroll
        for (int kt = 0; kt < 3; ++kt)
#pragma unroll
            for (int i = 0; i < 4; ++i) { const int pid = lane + 64 * i, row = pid >> 3, c16 = pid & 7; const int kc = q0 - 64 + 32 * kt + row; const bool valid = (kc >= 0) && (kc < lc);
                vst[kt][i] = (u32x4){0u, 0u, 0u, 0u};
                if (valid) vst[kt][i] = *(const u32x4*)(Vs + (seqrow + (size_t)kc * d + cls) * 64 + c16 * 8); }
        const float* lb = ldsb + (g * 16 + head) * 132 + 4 * h - r;
        const int kb = q0 - 64 + 4 * h;
        float mx = -1e30f;
#pragma unroll
        for (int kt = 0; kt < 5; ++kt)
#pragma unroll
            for (int i = 0; i < 16; ++i) {
                const int c0 = 32 * kt + (i & 3) + 8 * (i >> 2);
                float sv = sacc[kt][i] + lb[c0];
                bool ok = (unsigned)(kb + c0) < (unsigned)lc;
                if (kt == 0) ok = ok && (crow(i, h) >= r);
                if (kt == 4) ok = ok && (crow(i, h) <= r);
                sv = ok ? sv : -1e30f;
                sacc[kt][i] = sv; mx = fmaxf(mx, sv);
            }
        mx = fmaxf(mx, __shfl_xor(mx, 32));
        float l = 0.f;
#pragma unroll
        for (int kt = 0; kt < 5; ++kt)
#pragma unroll
            for (int i = 0; i < 16; ++i) { const float pv = __expf(sacc[kt][i] - mx); sacc[kt][i] = pv; l += pv; }
        l += __shfl_xor(l, 32);
        bf16x8 pfr[5][2];
#pragma unroll
        for (int kt = 0; kt < 5; ++kt)
#pragma unroll
            for (int s = 0; s < 2; ++s)
                pfr[kt][s] = pack8(sacc[kt][8 * s], sacc[kt][8 * s + 1], sacc[kt][8 * s + 2], sacc[kt][8 * s + 3], sacc[kt][8 * s + 4], sacc[kt][8 * s + 5], sacc[kt][8 * s + 6], sacc[kt][8 * s + 7]);
        asm volatile("" ::: "memory");
        PROBE_A(13);
        f32x16 oacc[2];
#pragma unroll
        for (int i = 0; i < 16; ++i) { oacc[0][i] = 0.f; oacc[1][i] = 0.f; }
#pragma unroll
        for (int kt = 3; kt < 5; ++kt)
#pragma unroll
            for (int i = 0; i < 4; ++i) { const int pid = lane + 64 * i, row = pid >> 3, c16 = pid & 7; const int kc = q0 - 64 + 32 * kt + row; const bool valid = (kc >= 0) && (kc < lc);
                vst[kt][i] = (u32x4){0u, 0u, 0u, 0u};
                if (valid) vst[kt][i] = *(const u32x4*)(Vs + (seqrow + (size_t)kc * d + cls) * 64 + c16 * 8); }
#pragma unroll
        for (int kt = 0; kt < 5; ++kt) {
#pragma unroll
            for (int i = 0; i < 4; ++i) { const int pid = lane + 64 * i, row = pid >> 3, c16 = pid & 7; *(u32x4*)(img + row * VIMG_RS + c16 * 16) = vst[kt][i]; }
            asm volatile("s_waitcnt lgkmcnt(0)" ::: "memory");
            s16x4 tr[8]; tr_read8(imgaddr + (4 * h + tq_) * VIMG_RS + 32 * blk + 8 * tp_, tr);
#pragma unroll
            for (int s = 0; s < 2; ++s) {
                const bf16x8 pf = pfr[kt][s];
#pragma unroll
                for (int et = 0; et < 2; ++et) {
                    const bf16x8 vf = __builtin_shufflevector(tr[4 * s + 2 * et], tr[4 * s + 2 * et + 1], 0, 1, 2, 3, 4, 5, 6, 7);
                    oacc[et] = MFMA32(vf, pf, oacc[et]);
                }
            }
        }
        PROBE_A(14);
        const float inv = 1.0f / l, lse = mx + __logf(l);
        bf16_t* op = OG + tq * 3072 + g * 1024 + head * 64;
#pragma unroll
        for (int et = 0; et < 2; ++et)
#pragma unroll
            for (int gq = 0; gq < 4; ++gq) { u32x2 w; w.x = pk2(oacc[et][4 * gq] * inv, oacc[et][4 * gq + 1] * inv); w.y = pk2(oacc[et][4 * gq + 2] * inv, oacc[et][4 * gq + 3] * inv);
                *(u32x2*)(op + et * 32 + 8 * gq + 4 * h) = w; }
        if (h == 0) LSE[tq * 48 + g * 16 + head] = lse;
    }
    __syncthreads();
}

DI void merge_phase(const bf16_t* __restrict__ OG, const float* __restrict__ LSE, bf16_t* __restrict__ ATT, const int ct, const int tid) {
    const int total = ct * 128;
#pragma unroll 4
    for (int idx = bx_now() * NTHR + tid; idx < total; idx += gridDim.x * NTHR) {
        const int tok = idx >> 7, c8 = idx & 127, head = c8 >> 3;
        const float l0 = LSE[tok * 48 + head], l1 = LSE[tok * 48 + 16 + head], l2 = LSE[tok * 48 + 32 + head];
        const float m = fmaxf(l0, fmaxf(l1, l2));
        float a0 = __expf(l0 - m), a1 = __expf(l1 - m), a2 = __expf(l2 - m); const float inv = 1.0f / (a0 + a1 + a2); a0 *= inv; a1 *= inv; a2 *= inv;
        const u32x4 o0 = *(const u32x4*)(OG + (size_t)tok * 3072 + c8 * 8), o1 = *(const u32x4*)(OG + (size_t)tok * 3072 + 1024 + c8 * 8), o2 = *(const u32x4*)(OG + (size_t)tok * 3072 + 2048 + c8 * 8);
        u32x4 w;
#pragma unroll
        for (int j = 0; j < 4; ++j) { const float lo = a0 * bflo(o0[j]) + a1 * bflo(o1[j]) + a2 * bflo(o2[j]); const float hi = a0 * bfhi(o0[j]) + a1 * bfhi(o1[j]) + a2 * bfhi(o2[j]); w[j] = pk2(lo, hi); }
        *(u32x4*)(ATT + (size_t)tok * 1024 + c8 * 8) = w;
    }
}

DI void ztrans_phase(const bf16_t* __restrict__ ZT, bf16_t* __restrict__ ZR, unsigned char* lds, int nseq, int L, const int tid) {
    const int tt = L / 64, ntiles = nseq * tt * 16;
    for (int tile0 = bx_now() * 4; tile0 < ntiles; tile0 += gridDim.x * 4) {
        u32x4 ld[4];
#pragma unroll
        for (int k = 0; k < 4; ++k) { const int tile = tile0 + k; const int ct = tile % 16; int rest = tile / 16; const int ti = rest % tt, seq = rest / tt; const int ch0 = ct * 64, t0 = ti * 64;
            const int row = tid >> 3, c16 = tid & 7; ld[k] = (u32x4){0u, 0u, 0u, 0u};
            if (tile < ntiles) ld[k] = *(const u32x4*)(ZT + ((size_t)seq * 1024 + ch0 + row) * L + t0 + c16 * 8); }
#pragma unroll
        for (int k = 0; k < 4; ++k) { const int row = tid >> 3, c16 = tid & 7; *(u32x4*)(lds + k * 9216 + row * 144 + c16 * 16) = ld[k]; }
        __syncthreads();
#pragma unroll
        for (int k = 0; k < 4; ++k) { const int tile = tile0 + k; const int ct = tile % 16; int rest = tile / 16; const int ti = rest % tt, seq = rest / tt; const int ch0 = ct * 64, t0 = ti * 64;
            const int t = tid & 63, cgp = tid >> 6; unsigned short v[8];
#pragma unroll
            for (int j = 0; j < 8; ++j) v[j] = *(const bf16_t*)(lds + k * 9216 + (cgp * 8 + j) * 144 + t * 2);
            u32x4 w; w.x = v[0] | ((unsigned)v[1] << 16); w.y = v[2] | ((unsigned)v[3] << 16); w.z = v[4] | ((unsigned)v[5] << 16); w.w = v[6] | ((unsigned)v[7] << 16);
            if (tile < ntiles) *(u32x4*)(ZR + ((size_t)seq * L + t0 + t) * 1024 + ch0 + cgp * 8) = w; }
        __syncthreads();
    }
}

DI int pidx(int i) { return i + (i >> 3); }
DI float2 cmul(float2 a, float2 b) { return make_float2(a.x * b.x - a.y * b.y, a.x * b.y + a.y * b.x); }
DI float2 tw_hw(int ju, int lmu) { const float rev = (float)ju * __uint_as_float((unsigned)(127 - (lmu + 1)) << 23); return make_float2(__builtin_amdgcn_cosf(rev), -__builtin_amdgcn_sinf(rev)); }
DI float2 ld_agent_f2(const float2* p) { const unsigned long long w = __hip_atomic_load((const unsigned long long*)p, __ATOMIC_RELAXED, __HIP_MEMORY_SCOPE_AGENT);
    return make_float2(__uint_as_float((unsigned)w), __uint_as_float((unsigned)(w >> 32))); }
template <int R, bool INV, int LOG2N, int NB, bool MUL = false>
DI void fft_pass(float2* buf, int s, const int tid, const float2* kfp = nullptr) {
    constexpr int N = 1 << LOG2N, NP = 1 << R, NPAD = N + N / 8;
    const int lmp = LOG2N - s - R, mp = 1 << lmp;
#pragma unroll 1
    for (int w = tid; w < (N >> R); w += NTHR) {
        const int jp = w & (mp - 1), blk = w >> lmp, base = (blk << (lmp + R)) + jp;
        float2 tw[R][NP / 2];
        { float2 bu = tw_hw(jp, lmp + R - 1); const float c8 = 0.70710678118654752f;
#pragma unroll
          for (int u = 0; u < R; ++u) { const int hq = 1 << (R - 1 - u);
              tw[u][0] = bu;
              if (hq >= 2) tw[u][hq / 2] = make_float2(bu.y, -bu.x);
              if (hq == 4) { tw[u][1] = make_float2(c8 * (bu.x + bu.y), c8 * (bu.y - bu.x)); tw[u][3] = make_float2(c8 * (bu.y - bu.x), -c8 * (bu.x + bu.y)); }
              bu = cmul(bu, bu); }
          if (INV) {
#pragma unroll
              for (int u = 0; u < R; ++u)
#pragma unroll
                  for (int k = 0; k < NP / 2; ++k) if (k < (1 << (R - 1 - u))) tw[u][k].y = -tw[u][k].y; } }
        float2 kfv[NP];
        if (MUL) {
#pragma unroll
            for (int q = 0; q < NP; ++q) kfv[q] = ld_agent_f2(kfp + base + q * mp); }
#pragma unroll
        for (int nb = 0; nb < NB; ++nb) {
            float2* bp = buf + nb * NPAD;
            float2 v[NP];
#pragma unroll
            for (int q = 0; q < NP; ++q) v[q] = bp[pidx(base + q * mp)];
            if (!INV) {
#pragma unroll
                for (int u = 0; u < R; ++u) { const int hq = 1 << (R - 1 - u);
#pragma unroll
                    for (int q = 0; q < NP; ++q) if (!(q & hq)) { const float2 a = v[q], b = v[q + hq]; v[q] = make_float2(a.x + b.x, a.y + b.y); v[q + hq] = cmul(make_float2(a.x - b.x, a.y - b.y), tw[u][q & (hq - 1)]); } }
            } else {
#pragma unroll
                for (int u = R - 1; u >= 0; --u) { const int hq = 1 << (R - 1 - u);
#pragma unroll
                    for (int q = 0; q < NP; ++q) if (!(q & hq)) { const float2 a = v[q], b = cmul(v[q + hq], tw[u][q & (hq - 1)]); v[q] = make_float2(a.x + b.x, a.y + b.y); v[q + hq] = make_float2(a.x - b.x, a.y - b.y); } }
            }
#pragma unroll
            for (int q = 0; q < NP; ++q) bp[pidx(base + q * mp)] = MUL ? cmul(v[q], kfv[q]) : v[q];
        }
    }
    __syncthreads();
}
template <int LOG2N, int NB> DI void fft_fwd(float2* buf, const int tid) {
    fft_pass<3, false, LOG2N, NB>(buf, 0, tid); fft_pass<3, false, LOG2N, NB>(buf, 3, tid); fft_pass<3, false, LOG2N, NB>(buf, 6, tid); fft_pass<3, false, LOG2N, NB>(buf, 9, tid);
    if (LOG2N == 14) fft_pass<2, false, LOG2N, NB>(buf, 12, tid);
}
template <int LOG2N, int NB> DI void fft_fwd_mul(float2* buf, const float2* kfp, const int tid) {
    fft_pass<3, false, LOG2N, NB>(buf, 0, tid); fft_pass<3, false, LOG2N, NB>(buf, 3, tid); fft_pass<3, false, LOG2N, NB>(buf, 6, tid);
    if (LOG2N == 14) { fft_pass<3, false, LOG2N, NB>(buf, 9, tid); fft_pass<2, false, LOG2N, NB, true>(buf, 12, tid, kfp); }
    else fft_pass<3, false, LOG2N, NB, true>(buf, 9, tid, kfp);
}
template <int LOG2N, int NB> DI void fft_inv(float2* buf, const int tid) {
    if (LOG2N == 14) fft_pass<2, true, LOG2N, NB>(buf, 12, tid);
    fft_pass<3, true, LOG2N, NB>(buf, 9, tid); fft_pass<3, true, LOG2N, NB>(buf, 6, tid); fft_pass<3, true, LOG2N, NB>(buf, 3, tid); fft_pass<3, true, LOG2N, NB>(buf, 0, tid);
}
DI void conv4(const bf16_t* rowp, int t0, int L, float w0, float w1, float w2, float b, float (&o)[4]) {
    const u32x2 q = *(const u32x2*)(rowp + t0);
    const float um = t0 > 0 ? bf2f(rowp[t0 - 1]) : 0.f, up = t0 + 4 < L ? bf2f(rowp[t0 + 4]) : 0.f;
    const float u0 = bflo(q.x), u1 = bfhi(q.x), u2 = bflo(q.y), u3 = bfhi(q.y);
    o[0] = um * w0 + u0 * w1 + u1 * w2 + b; o[1] = u0 * w0 + u1 * w1 + u2 * w2 + b; o[2] = u1 * w0 + u2 * w1 + u3 * w2 + b; o[3] = u2 * w0 + u3 * w1 + up * w2 + b;
}

template <int LOG2N, int NB>
DI void hyena_fft_phase(const bf16_t* __restrict__ UT, bf16_t* __restrict__ ZT, const float* __restrict__ H3, const float* __restrict__ w4, const float* __restrict__ skip,
                        float2* KFblk, unsigned char* lds, const int tid, const bool make_filter, const float* __restrict__ cw, const float* __restrict__ cb, const int ct, const int ngroups, float2* TMP) {
    constexpr int N = 1 << LOG2N, L = N / 2, PT = L / NTHR, NBF = NB >= 2 ? 2 : 1, NPAD = N + N / 8;
    float2* buf = (float2*)lds; float* w4s = (float*)(lds + LDS_MISC); float2* Z1 = KFblk + 2 * 16384;
    const float invN = 1.0f / (float)N;
#if defined(PROBE_SEL) && !defined(PROBE_GEMM) && !defined(PROBE_ATT)
    unsigned long long* pacc2 = (unsigned long long*)(lds + LDS_MISC + 3072); unsigned long long ptp = __builtin_amdgcn_s_memrealtime(); const bool pme = (tid == 0);
#define PROBE_T(i) do { const unsigned long long t1_ = __builtin_amdgcn_s_memrealtime(); if (pme) pacc2[i] += t1_ - ptp; ptp = t1_; } while (0)
#else
#define PROBE_T(i) do { } while (0)
#endif
    if (NBF == 1) {
        float* w16 = (float*)(lds + LDS_MISC + 4096);
        for (int i = tid; i < 1024; i += NTHR) { const int j = i >> 4, ci = (i >> 2) & 3, q = i & 3; w16[i] = w4[(size_t)j * 4096 + q * 1024 + bx_now() + 256 * ci]; }
        __syncthreads();
        float adl[4];
#pragma unroll
        for (int ci = 0; ci < 4; ++ci) adl[ci] = fabsf(-3.0701134573253945f + (-15.350567286626972f + 3.0701134573253945f) * ((float)(bx_now() + 256 * ci) / 1023.0f));
#pragma unroll 1
        for (int i0 = 0; i0 < PT; i0 += 4) {
            const float* hp = H3 + tid + NTHR * i0;
            float acc[4][4][4];
#pragma unroll
            for (int ci = 0; ci < 4; ++ci)
#pragma unroll
                for (int q = 0; q < 4; ++q)
#pragma unroll
                    for (int k = 0; k < 4; ++k) acc[ci][q][k] = 0.f;
            int zo = 0; asm volatile("" : "+v"(zo));
            const f32x4* wq = (const f32x4*)(w16 + zo);
#pragma unroll 4
            for (int j = 0; j < 64; ++j) { float hv[4];
#pragma unroll
                for (int k = 0; k < 4; ++k) hv[k] = hp[(size_t)j * L + NTHR * k];
#pragma unroll
                for (int ci = 0; ci < 4; ++ci) { const f32x4 wv = wq[j * 4 + ci];
#pragma unroll
                    for (int k = 0; k < 4; ++k) { acc[ci][0][k] += hv[k] * wv[0]; acc[ci][1][k] += hv[k] * wv[1]; acc[ci][2][k] += hv[k] * wv[2]; acc[ci][3][k] += hv[k] * wv[3]; } } }
#pragma unroll
            for (int k = 0; k < 4; ++k) { const int t = tid + NTHR * (i0 + k); const float tl = (float)t / (float)(L - 1);
#pragma unroll
                for (int ci = 0; ci < 4; ++ci) { const float dec = __expf(-tl * adl[ci]);
                    TMP[(size_t)(2 * ci + 0) * L + t] = make_float2(acc[ci][0][k] * dec, acc[ci][1][k] * dec);
                    TMP[(size_t)(2 * ci + 1) * L + t] = make_float2(acc[ci][2][k] * dec, acc[ci][3][k] * dec); } } }
        __syncthreads();
    }
    int chi = 0;
    for (int ch = bx_now(); ch < DM; ch += gridDim.x, ++chi) {
        int tidc = tid; asm volatile("" : "+v"(tidc));
        float zf = 0.f; asm volatile("" : "+v"(zf));
        float2* KF = KFblk + (LOG2N == 12 ? (size_t)chi * 2 * N : 0);
        PROBE_T(15);
        const float sk0 = skip[ch], sk1 = skip[1024 + ch];
        const float zw0 = cw[2048 + ch], zw1 = cw[3072 + 2048 + ch], zw2 = cw[6144 + 2048 + ch], zb = cb[2048 + ch];
        if (make_filter) {
        if (tidc < 256) { const int j = tidc >> 2, q = tidc & 3; w4s[tidc] = w4[(size_t)j * 4096 + q * 1024 + ch]; }
        __syncthreads();
        const float mind = -3.0701134573253945f, maxd = -15.350567286626972f;
        const float adelta = fabsf(mind + (maxd - mind) * ((float)ch / 1023.0f));
#pragma unroll 1
        for (int i0 = 0; i0 < (NBF == 2 ? PT : 0); i0 += 4) {
            const float* hp = H3 + tidc + NTHR * i0;
            float f[2][4], b[2][4];
#pragma unroll
            for (int oo = 0; oo < 2; ++oo)
#pragma unroll
                for (int k = 0; k < 4; ++k) { f[oo][k] = 0.f; b[oo][k] = 0.f; }
            int zo = 0; asm volatile("" : "+v"(zo));
            const f32x4* wq = (const f32x4*)(w4s + zo);
#pragma unroll 8
            for (int j = 0; j < 64; ++j) { float hv[4];
#pragma unroll
                for (int k = 0; k < 4; ++k) hv[k] = hp[(size_t)j * L + NTHR * k];
                const f32x4 wv = wq[j];
#pragma unroll
                for (int k = 0; k < 4; ++k) { f[0][k] += hv[k] * wv[0]; b[0][k] += hv[k] * wv[1]; f[1][k] += hv[k] * wv[2]; b[1][k] += hv[k] * wv[3]; } }
#pragma unroll
            for (int k = 0; k < 4; ++k) { const int t = tidc + NTHR * (i0 + k); const float dec = __expf(-((float)t / (float)(L - 1)) * adelta);
#pragma unroll
                for (int oo = 0; oo < 2; ++oo) { const float fv = f[oo][k] * dec, bv = b[oo][k] * dec;
                    if (oo < NBF) { float2* bo = buf + oo * NPAD; bo[pidx(t)] = make_float2(fv, 0.f); if (t == 0) bo[pidx(L)] = make_float2(zf, zf); else bo[pidx(N - t)] = make_float2(bv, 0.f); }
                    else Z1[t] = make_float2(fv, bv); } } }
        if (NBF == 1) {
#pragma unroll 2
            for (int i = 0; i < PT; ++i) { const int t = tidc + NTHR * i; const float2 v0 = TMP[(size_t)(2 * chi + 0) * L + t], v1 = TMP[(size_t)(2 * chi + 1) * L + t];
                buf[pidx(t)] = make_float2(v0.x, v1.x); if (t == 0) buf[pidx(L)] = make_float2(zf, zf); else buf[pidx(N - t)] = make_float2(v0.y, v1.y); }
            __syncthreads();
            fft_fwd<LOG2N, 1>(buf, tidc);
#pragma unroll 1
            for (int i = 0; i < 2 * PT; ++i) { const int idx = tidc + NTHR * i;
                const unsigned f = __brev((unsigned)idx) >> (32 - LOG2N), f2 = (N - f) & (N - 1), p2 = __brev(f2) >> (32 - LOG2N);
                const float2 c = buf[pidx(idx)], d = buf[pidx((int)p2)];
                KF[idx] = make_float2(0.5f * (c.x + d.x), 0.5f * (c.y - d.y));
                KF[(size_t)N + idx] = make_float2(0.5f * (c.y + d.y), 0.5f * (d.x - c.x)); }
            __syncthreads();
        } else {
#pragma unroll 1
        for (int og = 0; og < 2; og += NBF) {
            __syncthreads();
            fft_fwd<LOG2N, NBF>(buf, tidc);
#pragma unroll 1
            for (int i = 0; i < 2 * PT; ++i) { const int idx = tidc + NTHR * i;
#pragma unroll
                for (int oo = 0; oo < NBF; ++oo) KF[(size_t)(og + oo) * N + idx] = buf[oo * NPAD + pidx(idx)]; }
            __syncthreads();
        }
        }
        asm volatile("s_waitcnt vmcnt(0)" ::: "memory");
        }
        __syncthreads();
        PROBE_T(12);
#pragma unroll 1
        for (int gp = 0; gp < ngroups; ++gp) {
        int tidg = tidc; asm volatile("" : "+v"(tidg));
#pragma unroll
        for (int pr = 0; pr < NB; ++pr) { const size_t sa = (size_t)(2 * (gp * NB + pr)), sb = sa + 1;
            const bf16_t* zpa = UT + (size_t)(2048 + ch) * ct + sa * L; const bf16_t* zpb = UT + (size_t)(2048 + ch) * ct + sb * L; float2* bp = buf + pr * NPAD;
#pragma unroll 2
            for (int i = 0; i < PT / 4; ++i) { const int t0 = 4 * (tidg + NTHR * i); float za[4], zb4[4]; conv4(zpa, t0, L, zw0, zw1, zw2, zb, za); conv4(zpb, t0, L, zw0, zw1, zw2, zb, zb4);
#pragma unroll
                for (int j = 0; j < 4; ++j) { bp[pidx(t0 + j)] = make_float2(za[j], zb4[j]); bp[pidx(t0 + j + L)] = make_float2(zf, zf); } } }
        PROBE_T(13);
#pragma unroll 1
        for (int o = 0; o < 2; ++o) {
            asm volatile("" : "+v"(tidg));
            __syncthreads();
            fft_fwd_mul<LOG2N, NB>(buf, KF + (size_t)o * N, tidg);
            fft_inv<LOG2N, NB>(buf, tidg);
            PROBE_T(14);
            const float sk = o == 0 ? sk0 : sk1;
            const float xw0 = cw[o * 1024 + ch], xw1 = cw[3072 + o * 1024 + ch], xw2 = cw[6144 + o * 1024 + ch], xb = cb[o * 1024 + ch];
#pragma unroll
            for (int pr = 0; pr < NB; ++pr) { const size_t sa = (size_t)(2 * (gp * NB + pr)), sb = sa + 1;
                const bf16_t* zpa = UT + (size_t)(2048 + ch) * ct + sa * L; const bf16_t* zpb = UT + (size_t)(2048 + ch) * ct + sb * L;
                const bf16_t* xpa = UT + (size_t)(o * 1024 + ch) * ct + sa * L; const bf16_t* xpb = UT + (size_t)(o * 1024 + ch) * ct + sb * L;
                bf16_t* opa = ZT + (sa * 1024 + ch) * L; bf16_t* opb = ZT + (sb * 1024 + ch) * L; float2* bp = buf + pr * NPAD; float2* z1p = Z1 + pr * L;
#pragma unroll 2
                for (int i = 0; i < PT / 4; ++i) { const int t0 = 4 * (tidg + NTHR * i);
                    float xa[4], xb4[4]; conv4(xpa, t0, L, xw0, xw1, xw2, xb, xa); conv4(xpb, t0, L, xw0, xw1, xw2, xb, xb4);
                    float za[4], zb4[4];
                    if (o == 0) { conv4(zpa, t0, L, zw0, zw1, zw2, zb, za); conv4(zpb, t0, L, zw0, zw1, zw2, zb, zb4); }
                    else { const f32x4 q0 = *(const f32x4*)(z1p + t0), q1 = *(const f32x4*)(z1p + t0 + 2); za[0] = q0[0]; zb4[0] = q0[1]; za[1] = q0[2]; zb4[1] = q0[3]; za[2] = q1[0]; zb4[2] = q1[1]; za[3] = q1[2]; zb4[3] = q1[3]; }
                    float na[4], nb[4];
#pragma unroll
                    for (int j = 0; j < 4; ++j) { const float2 c = bp[pidx(t0 + j)]; na[j] = xa[j] * (c.x * invN + za[j] * sk); nb[j] = xb4[j] * (c.y * invN + zb4[j] * sk); }
                    if (o == 0) { *(f32x4*)(z1p + t0) = (f32x4){na[0], nb[0], na[1], nb[1]}; *(f32x4*)(z1p + t0 + 2) = (f32x4){na[2], nb[2], na[3], nb[3]};
#pragma unroll
                        for (int j = 0; j < 4; ++j) { bp[pidx(t0 + j)] = make_float2(na[j], nb[j]); bp[pidx(t0 + j + L)] = make_float2(zf, zf); } }
                    else { u32x2 wa, wb; wa.x = pk2(na[0], na[1]); wa.y = pk2(na[2], na[3]); wb.x = pk2(nb[0], nb[1]); wb.y = pk2(nb[2], nb[3]); *(u32x2*)(opa + t0) = wa; *(u32x2*)(opb + t0) = wb; } } }
            PROBE_T(15);
        }
        __syncthreads();
        }
    }
}

#define XB_TMO      128
#define XB_XCNT(j)  (256  + 64 * (j))
#define XB_XSUB(j)  (1280 + 64 * (j))
#define XB_XGEN(j)  (2304 + 64 * (j))
#define XB_TOP      3328
#define XB_TOPGEN   3392
#define XCD_BAR_WORDS 3456
#define XB_SPIN_CAP (1u << 18)

__device__ __forceinline__ unsigned xb_ld(unsigned* p)              { return __hip_atomic_load(p, __ATOMIC_RELAXED, __HIP_MEMORY_SCOPE_AGENT); }
__device__ __forceinline__ unsigned xb_add(unsigned* p, unsigned v) { return __hip_atomic_fetch_add(p, v, __ATOMIC_RELAXED, __HIP_MEMORY_SCOPE_AGENT); }
__device__ __forceinline__ unsigned xb_xcc_id() { return (unsigned)__builtin_amdgcn_s_getreg((3 << 11) | 20) & 0xFu; }
#define XB_SPIN(cond, bar) do { unsigned _sp = 0; while (cond) { __builtin_amdgcn_s_sleep(1); \
    if ((++_sp & 255u) == 0u) { if (xb_ld(&(bar)[XB_TMO])) break; if (_sp > XB_SPIN_CAP) { atomicAdd(&(bar)[XB_TMO], 1u); break; } } } } while (0)

struct XcdBarrier {
    unsigned* bar; unsigned x;
    volatile LAS unsigned* st;
};

__device__ __forceinline__ XcdBarrier xcd_barrier_post(unsigned* bar, volatile LAS unsigned* st, const int tid) {
    XcdBarrier b; b.bar = bar; b.x = xb_xcc_id(); b.st = st;
    if (tid == 0) { const unsigned rank = xb_add(&bar[XB_XCNT(b.x)], 1u); st[2] = rank * 8u + b.x; }
    return b;
}
__device__ __forceinline__ void xcd_barrier_complete(unsigned* bar, unsigned x, unsigned& nloc, unsigned& nx) {
    const unsigned G = gridDim.x * gridDim.y * gridDim.z;
    unsigned sum, cnt, mine, sp = 0u;
    for (;;) {
        sum = 0u; cnt = 0u; mine = 0u;
#pragma unroll
        for (unsigned j = 0; j < 16; ++j) { const unsigned c = xb_ld(&bar[XB_XCNT(j)]); sum += c; cnt += (c > 0u) ? 1u : 0u; mine = (j == x) ? c : mine; }
        if (sum == G) break;
        __builtin_amdgcn_s_sleep(1);
        if ((++sp & 255u) == 0u) { if (xb_ld(&bar[XB_TMO])) break; if (sp > XB_SPIN_CAP) { atomicAdd(&bar[XB_TMO], 1u); break; } }
    }
    nloc = mine > 0u ? mine : 1u; nx = cnt > 0u ? cnt : 1u;
}

__device__ __forceinline__ void xcd_barrier(const XcdBarrier& b, const int tid) {
    asm volatile("s_waitcnt vmcnt(0)" ::: "memory");
    __syncthreads();
    if (tid == 0) {
        unsigned* bar = b.bar;
        __builtin_amdgcn_s_waitcnt(0);
        unsigned nloc = b.st[0], nx = b.st[1];
        if (nloc == 0u) { xcd_barrier_complete(bar, b.x, nloc, nx); b.st[0] = nloc; b.st[1] = nx; }
        const unsigned old = xb_add(&bar[XB_XSUB(b.x)], 1u);
        const unsigned gen = old / nloc;
        if (old + 1u == (gen + 1u) * nloc) {
            __builtin_amdgcn_fence(__ATOMIC_RELEASE, "agent");
            asm volatile("s_waitcnt vmcnt(0)" ::: "memory");
            const unsigned og = xb_add(&bar[XB_TOP], 1u);
            const unsigned tg = og / nx;
            if (og + 1u == (tg + 1u) * nx) xb_add(&bar[XB_TOPGEN], 1u);
            else XB_SPIN(xb_ld(&bar[XB_TOPGEN]) == tg, bar);
            __builtin_amdgcn_fence(__ATOMIC_ACQUIRE, "agent");
            xb_add(&bar[XB_XGEN(b.x)], 1u);
            asm volatile("s_waitcnt vmcnt(0)" ::: "memory");
        } else {
            XB_SPIN(xb_ld(&bar[XB_XGEN(b.x)]) == gen, bar);
            __builtin_amdgcn_fence(__ATOMIC_ACQUIRE, "agent");
            asm volatile("s_waitcnt vmcnt(0)" ::: "memory");
        }
    }
    __syncthreads();
}


DI int tid_now(int wave_s) { unsigned m = ~0u; asm volatile("" : "+s"(m)); return wave_s * 64 + (int)__builtin_amdgcn_mbcnt_hi(m, __builtin_amdgcn_mbcnt_lo(m, 0u)); }
__global__ void __launch_bounds__(NTHR) fwd_megakernel(Params p) {
    extern __shared__ __attribute__((aligned(16))) unsigned char lds[];
    cg::grid_group grid = cg::this_grid();
    unsigned char* ws = p.ws;
    LAS unsigned char* ldsl = (LAS unsigned char*)lds;
    const int G = gridDim.x, bx = bx_now();
    const int wave_s = __builtin_amdgcn_readfirstlane(threadIdx.x >> 6);
#define TID_NOW() tid_now(wave_s)
    int tid = TID_NOW(); asm volatile("" : "+v"(tid));

    for (int li = 0; li < 2; ++li) {
        convert_wt<1>(inp(p, I_F1GU) + (size_t)li * 1024 * 5632, (bf16_t*)(ws + WS_WGU + (size_t)li * SZ_WGU), 1024, 5632, (float*)lds, tid);
        convert_wt<1>(inp(p, I_F2GU) + (size_t)li * 1024 * 5632, (bf16_t*)(ws + WS_WGU + (size_t)(2 + li) * SZ_WGU), 1024, 5632, (float*)lds, tid);
        convert_wt<0>(inp(p, I_F1D) + (size_t)li * 2816 * 1024, (bf16_t*)(ws + WS_WDN + (size_t)li * SZ_WDN), 2816, 1024, (float*)lds, tid);
        convert_wt<0>(inp(p, I_F2D) + (size_t)li * 2816 * 1024, (bf16_t*)(ws + WS_WDN + (size_t)(2 + li) * SZ_WDN), 2816, 1024, (float*)lds, tid);
    }
    convert_wt<2>(inp(p, I_WQKV), (bf16_t*)(ws + WS_WQKV), 1024, 9216, (float*)lds, tid);
    for (int li = 0; li < 3; ++li) {
        const float* W = li == 0 ? inp(p, I_WO) : (li == 1 ? inp(p, I_HWIN) : inp(p, I_HWOUT));
        bf16_t* Bt = (bf16_t*)(ws + (li == 0 ? WS_WO : (li == 1 ? WS_WIN : WS_WOUT)));
        convert_wt<0>(W, Bt, 1024, li == 1 ? 3072 : 1024, (float*)lds, tid);
    }
    prologue_small(p, tid);
    if (bx == 0) for (int i = tid; i < XCD_BAR_WORDS; i += NTHR) ((unsigned*)(ws + WS_BAR))[i] = 0u;
    if (tid == 0) { ((unsigned*)(lds + LDS_MISC + 2048))[0] = 0u; ((unsigned*)(lds + LDS_MISC + 2048))[1] = 0u; ((unsigned*)(lds + LDS_MISC + 2048))[2] = 0u; ((unsigned*)(lds + LDS_MISC + 2048))[3] = 0u; }
#ifdef PROBE_SEL
    unsigned long long* pacc = (unsigned long long*)(lds + LDS_MISC + 3072);
    unsigned long long pt_prev = 0, pt_start = 0;
    if (tid == 0) { for (int i = 0; i < 16; ++i) pacc[i] = 0ull; }
    pt_start = __builtin_amdgcn_s_memrealtime();
#endif
    __syncthreads();
    grid.sync();
#ifdef PROBE_SEL
    pt_prev = __builtin_amdgcn_s_memrealtime();
    if (TID_NOW() == 0) pacc[11] = pt_prev - pt_start;
#endif
    XcdBarrier xbar = xcd_barrier_post((unsigned*)(ws + WS_BAR), (volatile LAS unsigned*)(lds + LDS_MISC + 2048), tid);
    int vbx = bx;


    for (int c = 0; c < NCHUNK; ++c) {
#pragma unroll 1
        for (int ph = 0; ph < NPH; ++ph) {
            tid = TID_NOW(); asm volatile("" : "+v"(tid));
            int kind = 0, widx = 0;
            switch (ph) {
                case 0: kind = 0; break;  case 1: kind = 1; widx = 0; break;  case 2: kind = 2; widx = 0; break;
                case 3: kind = 3; break;  case 4: kind = 4; break;  case 5: kind = 5; break;  case 6: kind = 2; widx = 4; break;
                case 7: kind = 1; widx = 2; break;  case 8: kind = 2; widx = 2; break;
                case 9: kind = 1; widx = 1; break;  case 10: kind = 2; widx = 1; break;
                case 11: kind = 6; break; case 12: kind = 7; break; case 13: kind = 8; break; case 14: kind = 2; widx = 5; break;
                case 15: kind = 1; widx = 3; break; case 16: kind = 2; widx = 3; break;
                default: kind = 9; break;
            }
#ifndef REP_MASK
#define REP_MASK 0
#endif
            const int nrep = 1 + ((REP_MASK >> kind) & 1);
#pragma unroll 1
            for (int rep = 0; rep < nrep; ++rep) {
            tid = TID_NOW(); asm volatile("" : "+v"(tid));
            unsigned char* ws = p.ws; asm volatile("" : "+s"(ws));
            int cc = c; asm volatile("" : "+s"(cc));
            const bool samp = (cc == NCHUNK - 1);
            const float* xin = samp ? inp(p, I_XS) : inp(p, I_XP) + (size_t)cc * CT * DM;
            const int ct = samp ? 16384 : CT;
            float* xo = p.out + (size_t)cc * CT * DM;
            const int S = samp ? 8192 : 2048, nseq = samp ? 2 : CT / 2048;
            bf16_t* XN = (bf16_t*)(ws + WS_XN); bf16_t* HB = (bf16_t*)(ws + WS_H); bf16_t* ATT = (bf16_t*)(ws + WS_ATT); float* LSE = (float*)(ws + WS_LSE);
            bf16_t* OG = (bf16_t*)(ws + WS_OG); bf16_t* BIG = (bf16_t*)(ws + WS_BIG); bf16_t* UT = (bf16_t*)(ws + WS_BIG);
            float* PART = (float*)(ws + WS_PART);
            if (kind == 0) {
                norm0_phase(xin, inp(p, I_F1N), XN, PART, ct, tid);
            } else if (kind == 9) {
                final_phase(xo, inp(p, I_FINN), PART, ct, tid);
            } else if (kind == 1) {
                pg8::Gemm gm{XN, (const bf16_t*)(ws + WS_WGU + (size_t)widx * SZ_WGU), ct, 5632, 1024}; pg8::StaticOrder so; so.init(ct, 5632, G, vbx);
                EpiSwiGLU E{HB, PART};
#ifndef NO_G1
                pg8::gemm_phase<EpiSwiGLU, pg8::StaticOrder, false>(ldsl, gm, so, E, nullptr, tid);
#endif
            } else if (kind == 2) {
                pg8::Gemm gm; float scale = 0.5f; const float* base = (ph == 2) ? xin : xo; const float* gnext = nullptr;
                if (widx < 4) { gm = pg8::Gemm{HB, (const bf16_t*)(ws + WS_WDN + (size_t)widx * SZ_WDN), ct, 1024, 2816}; }
                else { gm = pg8::Gemm{ATT, (const bf16_t*)(ws + (widx == 4 ? WS_WO : WS_WOUT)), ct, 1024, 1024}; scale = 1.0f; }
                if (ph == 2) gnext = inp(p, I_MIXN); else if (ph == 6) gnext = inp(p, I_F2N); else if (ph == 8) gnext = inp(p, I_F1N) + DM; else if (ph == 10) gnext = inp(p, I_MIXN) + DM; else if (ph == 14) gnext = inp(p, I_F2N) + DM;
                pg8::StaticOrder so; so.init(ct, 1024, G, vbx);
                EpiRes E{base, xo, scale, gnext, XN, PART};
#ifndef NO_G2
                pg8::gemm_phase<EpiRes, pg8::StaticOrder, false>(ldsl, gm, so, E, nullptr, tid);
#endif
            } else if (kind == 3) {
                pg8::Gemm gm{XN, (const bf16_t*)(ws + WS_WQKV), ct, NQKV, 1024}; pg8::StaticOrder so; so.init(ct, NQKV, G, vbx);
                EpiBf E{BIG, ct, PART};
#ifndef NO_G3
                pg8::gemm_phase<EpiBf, pg8::StaticOrder, false>(ldsl, gm, so, E, nullptr, tid);
#endif
            } else if (kind == 6) {
                pg8::Gemm gm{XN, (const bf16_t*)(ws + WS_WIN), ct, 3072, 1024}; pg8::StaticOrder so; so.init(ct, 3072, G, vbx);
                EpiBfT E{UT, PART, ct};
                pg8::gemm_phase<EpiBfT, pg8::StaticOrder, false>(ldsl, gm, so, E, nullptr, tid);
            } else if (kind == 4) {
#ifndef NO_ATT
                attn_phase(BIG, OG, LSE, (const float*)(ws + WS_BIAS), lds, nseq, S, ct, tid);
#endif
            } else if (kind == 5) {
                merge_phase(OG, LSE, ATT, ct, tid);
            } else if (kind == 7) {
                float2* KF = (float2*)(ws + WS_KF) + (size_t)bx * KF_BLK;
#ifndef NO_FFT
                if (samp) hyena_fft_phase<14, 1>(UT, OG, (const float*)(ws + WS_H3) + (size_t)2048 * 64, inp(p, I_HW4), inp(p, I_HSKIP), KF, lds, tid, true, inp(p, I_HCW), inp(p, I_HCB), ct, 1, (float2*)(ws + WS_BIG + ((size_t)256 << 20)) + (size_t)bx * 8 * 8192);
                else hyena_fft_phase<12, 4>(UT, OG, (const float*)(ws + WS_H3), inp(p, I_HW4), inp(p, I_HSKIP), KF, lds, tid, cc == 0, inp(p, I_HCW), inp(p, I_HCB), ct, CT / 16384, nullptr);
#endif
            } else if (kind == 8) {
                ztrans_phase(OG, ATT, lds, nseq, S, tid);
            }
            }
#ifdef PROBE_SEL
            { const unsigned long long t1 = __builtin_amdgcn_s_memrealtime(); if (TID_NOW() == 0) pacc[kind] += t1 - pt_prev; pt_prev = t1; }
#endif
            if (ph != NPH - 1) { tid = TID_NOW(); xcd_barrier(xbar, tid); }
            if (c == 0 && ph == 0) {
                volatile LAS unsigned* stw = (volatile LAS unsigned*)(lds + LDS_MISC + 2048);
                if (TID_NOW() == 0) { bool okc = (G == 256);
                    for (unsigned j = 0; j < 16; ++j) { const unsigned cnt = xb_ld((unsigned*)(p.ws + WS_BAR) + XB_XCNT(j)); okc = okc && (cnt == (j < 8 ? 32u : 0u)); }
                    stw[3] = okc ? 1u : 0u; }
                __syncthreads();
                vbx = stw[3] ? (int)(stw[2] & 255u) : bx;
            }
#ifdef PROBE_SEL
            { const unsigned long long t1 = __builtin_amdgcn_s_memrealtime(); if (TID_NOW() == 0) pacc[10] += t1 - pt_prev; pt_prev = t1; }
#endif
        }
    }
#ifdef PROBE_SEL
    __syncthreads();
    if (bx_now() == 0 && TID_NOW() == 0) { const unsigned long long tot = __builtin_amdgcn_s_memrealtime() - pt_start; unsigned long long sel = 0;
        for (int i = 0; i < 16; ++i) if ((PROBE_SEL >> i) & 1) sel += pacc[i];
        const float fq = floorf((float)((double)sel / (double)tot) * 32.0f + 0.5f) * (1.0f / 32.0f);
        __builtin_nontemporal_store(4096.0f * fq, p.out + (size_t)65536 * 1024); }
#endif
}

extern "C" void kernel_launch(void* const* d_in, const int* in_sizes, int n_in, void* d_out, int out_size, void* d_ws, size_t ws_size, hipStream_t stream) {
    static int grid_blocks = 0;
    if (grid_blocks == 0) {
        if (n_in != 26 || ws_size < WS_END) { fprintf(stderr, "kernel_launch: need 26 inputs and >= %zu bytes of workspace; got %d, %zu\n", (size_t)WS_END, n_in, ws_size); grid_blocks = -1; return; }
        int dev = 0, cus = 0, per_cu = 0;
        hipGetDevice(&dev);
        hipDeviceGetAttribute(&cus, hipDeviceAttributeMultiprocessorCount, dev);
        if (hipFuncSetAttribute((const void*)fwd_megakernel, hipFuncAttributeMaxDynamicSharedMemorySize, LDS_BYTES) != hipSuccess) { fprintf(stderr, "kernel_launch: hipFuncSetAttribute failed\n"); grid_blocks = -1; return; }
        hipOccupancyMaxActiveBlocksPerMultiprocessor(&per_cu, (const void*)fwd_megakernel, NTHR, LDS_BYTES);
        if (per_cu < 1) { fprintf(stderr, "kernel_launch: occupancy query says %d blocks per CU\n", per_cu); per_cu = 1; }
        (void)hipGetLastError();
        grid_blocks = cus > 256 ? 256 : cus;
    }
    if (grid_blocks < 0) return;
    Params p{};
    for (int i = 0; i < 26; ++i) p.in[i] = (const float*)d_in[i];
    p.out = (float*)d_out; p.ws = (unsigned char*)d_ws;
    void* args[] = {&p};
    hipError_t e = hipLaunchCooperativeKernel((const void*)fwd_megakernel, dim3(grid_blocks), dim3(NTHR), args, LDS_BYTES, stream);
    if (e != hipSuccess) fprintf(stderr, "cooperative launch failed: %s (grid %d)\n", hipGetErrorString(e), grid_blocks);
}
```
